# Optimizing an MI355X kernel written in HIP

```python
import jax
import jax.numpy as jnp
from jax import lax
import numpy as np

D_MODEL = 1024
BATCH = 8
SEQ = 2048
DEPTH = 4
DEC_BATCH = 128
DEC_SEQ = 8
PAST_LEN = 16384
PAGE_SIZE = 128

F32 = jnp.float32
N_MIXERS = 3
N_A = (DEPTH + 2) // N_MIXERS
N_B = (DEPTH + 1) // N_MIXERS
N_C = DEPTH // N_MIXERS
EXPAND = 2
BRANCH = EXPAND * D_MODEL
CONV_W = 4
EPS = 1e-6

LRU_WIDTH = BRANCH
LRU_BLOCKS = 8
LRU_BLOCK = LRU_WIDTH // LRU_BLOCKS
LRU_C = 8.0

SSD_HEAD_DIM = 64
SSD_HEADS = BRANCH // SSD_HEAD_DIM
SSD_STATE = 128
SSD_GROUPS = 8
SSD_CONV_DIM = BRANCH + 2 * SSD_GROUPS * SSD_STATE
SSD_CHUNK = 128

HGRN_KEY_DIM = 128
HGRN_HEADS = BRANCH // HGRN_KEY_DIM
HGRN_VAL_DIM = BRANCH // HGRN_HEADS
HGRN_CHUNK = 16

N_MEM = 256
X_HEADS = 4
X_HEAD_DIM = D_MODEL // X_HEADS

kernel_name = 'hybrid_rglru_ssd_hgrn2_memxattn_step'


def rms_norm(x, g):
    xf = x.astype(F32)
    y = xf * lax.rsqrt(jnp.mean(xf * xf, axis=-1, keepdims=True) + EPS)
    return (y * g.astype(F32)).astype(x.dtype)


def causal_conv(u, state, w, b):
    L = u.shape[1]
    uu = jnp.concatenate([state.astype(u.dtype), u], axis=1)
    y = b + w[0] * uu[:, 0:L]
    for k in range(1, CONV_W):
        y = y + w[k] * uu[:, k:k + L]
    return y, uu[:, L:]


def linear_scan(a, b):
    def combine(left, right):
        a_l, b_l = left
        a_r, b_r = right
        return a_l * a_r, a_r * b_l + b_r
    _, h = lax.associative_scan(combine, (a, b), axis=1)
    return h


def pad_seq(t, pad):
    if pad == 0:
        return t
    widths = [(0, 0)] * t.ndim
    widths[1] = (0, pad)
    return jnp.pad(t, widths)


def rglru_mixer(x, conv_state, h0, w_in, conv_w, conv_b, w_a, b_a, w_x, b_x, lam, w_out):
    bsz, L, _ = x.shape
    u, gate = jnp.split(x @ w_in, 2, axis=-1)
    u, new_conv = causal_conv(u, conv_state, conv_w, conv_b)
    ub = u.reshape(bsz, L, LRU_BLOCKS, LRU_BLOCK)
    r = jax.nn.sigmoid((jnp.einsum('blhi,hij->blhj', ub, w_a).reshape(bsz, L, LRU_WIDTH) + b_a).astype(F32))
    i = jax.nn.sigmoid((jnp.einsum('blhi,hij->blhj', ub, w_x).reshape(bsz, L, LRU_WIDTH) + b_x).astype(F32))
    log_a = -LRU_C * r * jax.nn.softplus(-lam.astype(F32))
    a = jnp.exp(log_a)
    b = jnp.sqrt(-jnp.expm1(2.0 * log_a)) * (i * u.astype(F32))
    b = b.at[:, 0].add(a[:, 0] * h0.astype(F32))
    h = linear_scan(a, b)
    y = (h.astype(x.dtype) * jax.nn.silu(gate)) @ w_out
    return y, new_conv, h[:, -1].astype(x.dtype)


def ssd_chunked(xs, dt, a, bm, cm, s0):
    bsz, L, H, P = xs.shape
    G, N = SSD_GROUPS, SSD_STATE
    J = H // G
    Q = min(SSD_CHUNK, L)
    pad = (-L) % Q
    xs, dt, bm, cm = (pad_seq(t, pad) for t in (xs, dt, bm, cm))
    nc = (L + pad) // Q
    x = xs.reshape(bsz, nc, Q, G, J, P)
    dt = dt.reshape(bsz, nc, Q, G, J)
    bc = bm.reshape(bsz, nc, Q, G, N)
    cc = cm.reshape(bsz, nc, Q, G, N)
    acs = jnp.cumsum(dt * a.reshape(G, J), axis=2)
    xdt = x * dt[..., None]
    causal = jnp.tril(jnp.ones((Q, Q), dtype=bool))[:, :, None, None]
    seg = acs[:, :, :, None] - acs[:, :, None, :]
    decay = jnp.exp(jnp.where(causal, seg, -jnp.inf))
    cb = jnp.einsum('bclgn,bcsgn->bclsg', cc, bc)
    y_diag = jnp.einsum('bclsg,bclsgj,bcsgjp->bclgjp', cb, decay, xdt)
    decay_states = jnp.exp(acs[:, :, -1:] - acs)
    states = jnp.einsum('bclgn,bclgj,bclgjp->bcgjpn', bc, decay_states, xdt)
    chunk_decay = jnp.exp(acs[:, :, -1])

    def step(s, inp):
        st, dec = inp
        return s * dec[..., None, None] + st, s

    s_final, starts = lax.scan(step, s0.reshape(bsz, G, J, P, N),
                               (jnp.moveaxis(states, 1, 0), jnp.moveaxis(chunk_decay, 1, 0)))
    starts = jnp.moveaxis(starts, 0, 1)
    y_off = jnp.einsum('bclgn,bcgjpn,bclgj->bclgjp', cc, starts, jnp.exp(acs))
    y = (y_diag + y_off).reshape(bsz, nc * Q, H, P)[:, :L]
    return y, s_final.reshape(bsz, H, P, N)


def ssd_mixer(x, conv_state, s0, w_in, conv_w, conv_b, dt_bias, a_log, d_skip, norm_g, w_out):
    bsz, L, _ = x.shape
    proj = x @ w_in
    z = proj[..., :BRANCH]
    xbc = proj[..., BRANCH:BRANCH + SSD_CONV_DIM]
    dt_raw = proj[..., BRANCH + SSD_CONV_DIM:]
    xbc, new_conv = causal_conv(xbc, conv_state, conv_w, conv_b)
    xbc = jax.nn.silu(xbc).astype(F32)
    gn = SSD_GROUPS * SSD_STATE
    xs = xbc[..., :BRANCH].reshape(bsz, L, SSD_HEADS, SSD_HEAD_DIM)
    bm = xbc[..., BRANCH:BRANCH + gn].reshape(bsz, L, SSD_GROUPS, SSD_STATE)
    cm = xbc[..., BRANCH + gn:].reshape(bsz, L, SSD_GROUPS, SSD_STATE)
    dt = jax.nn.softplus(dt_raw.astype(F32) + dt_bias.astype(F32))
    a = -jnp.exp(a_log.astype(F32))
    y, s_new = ssd_chunked(xs, dt, a, bm, cm, s0.astype(F32))
    y = y + d_skip.astype(F32)[:, None] * xs
    y = y.reshape(bsz, L, BRANCH) * jax.nn.silu(z.astype(F32))
    yg = y.reshape(bsz, L, SSD_GROUPS, BRANCH // SSD_GROUPS)
    yg = yg * lax.rsqrt(jnp.mean(yg * yg, axis=-1, keepdims=True) + EPS)
    y = yg.reshape(bsz, L, BRANCH) * norm_g.astype(F32)
    return y.astype(x.dtype) @ w_out, new_conv, s_new.astype(x.dtype)


def gla_chunked(q, k, v, g, s0):
    bsz, L, H, _ = q.shape
    DV = v.shape[-1]
    Q = min(HGRN_CHUNK, L)
    pad = (-L) % Q
    nc = (L + pad) // Q

    def chunks(t):
        t = pad_seq(t, pad)
        return jnp.moveaxis(t.reshape(bsz, nc, Q, H, t.shape[-1]), 1, 0)

    causal = jnp.tril(jnp.ones((Q, Q), dtype=bool))

    def step(S, inp):
        qc, kc, vc, gc = inp
        G = jnp.cumsum(gc, axis=1)
        qg = qc * jnp.exp(G)
        att = jnp.einsum('blhd,bshd->bhls', qg, kc * jnp.exp(-G))
        att = jnp.where(causal, att, 0.0)
        o = jnp.einsum('bhls,bshv->blhv', att, vc) + jnp.einsum('blhd,bhdv->blhv', qg, S)
        g_last = G[:, -1]
        S = S * jnp.exp(g_last)[..., None] + jnp.einsum('bshd,bshv->bhdv', kc * jnp.exp(g_last[:, None] - G), vc)
        return S, o

    s_final, o = lax.scan(step, s0, (chunks(q), chunks(k), chunks(v), chunks(g)))
    o = jnp.moveaxis(o, 0, 1).reshape(bsz, nc * Q, H, DV)[:, :L]
    return o, s_final


def hgrn2_mixer(x, s0, lb, w_in, norm_g, w_out):
    bsz, L, _ = x.shape
    q, f, v, gate = jnp.split(x @ w_in, 4, axis=-1)
    shp = (bsz, L, HGRN_HEADS, HGRN_KEY_DIM)
    lb = lb.astype(F32)
    f = f.astype(F32)
    forget = lb + (1.0 - lb) * jax.nn.sigmoid(f)
    log_f = jnp.log(forget).reshape(shp)
    k = ((1.0 - lb) * jax.nn.sigmoid(-f)).reshape(shp)
    q = jax.nn.silu(q.astype(F32)).reshape(shp)
    v = v.astype(F32).reshape(bsz, L, HGRN_HEADS, HGRN_VAL_DIM)
    o, s_new = gla_chunked(q, k, v, log_f, s0.astype(F32))
    o = o * lax.rsqrt(jnp.mean(o * o, axis=-1, keepdims=True) + EPS)
    o = o.reshape(bsz, L, BRANCH) * norm_g.astype(F32) * jax.nn.silu(gate.astype(F32))
    return o.astype(x.dtype) @ w_out, s_new.astype(x.dtype)


def memory_kv(mem, g, w_k, w_v):
    m = rms_norm(mem, g)
    shp = mem.shape[:2] + (X_HEADS, X_HEAD_DIM)
    return (m @ w_k).reshape(shp), (m @ w_v).reshape(shp)


def memory_cross_attn(x, mem_k, mem_v, w_q, w_o):
    bsz, L, _ = x.shape
    q = (x @ w_q).reshape(bsz, L, X_HEADS, X_HEAD_DIM)
    s = jnp.einsum('blhd,bmhd->bhlm', q, mem_k.astype(q.dtype)).astype(F32) * (X_HEAD_DIM ** -0.5)
    p = jax.nn.softmax(s, axis=-1).astype(x.dtype)
    o = jnp.einsum('bhlm,bmhd->blhd', p, mem_v.astype(x.dtype)).reshape(bsz, L, D_MODEL)
    return o @ w_o


def run_trunk(x, mem_k, mem_v, rg_conv0, rg_h0, ssd_conv0, ssd_s0, hg_s0, P):
    cum = jnp.cumsum(jax.nn.softmax(P['hg_lower_bounds'].astype(F32), axis=0), axis=0)
    lower_bounds = cum - cum[0]
    rg_conv, rg_h, ssd_conv, ssd_s, hg_s = [], [], [], [], []
    for layer in range(DEPTH):
        kind, idx = layer % N_MIXERS, layer // N_MIXERS
        g = P['norm_g'][layer]
        h = rms_norm(x, g[0])
        if kind == 0:
            y, c_new, h_new = rglru_mixer(h, rg_conv0[idx], rg_h0[idx], P['rg_w_in'][idx], P['rg_conv_w'][idx],
                                          P['rg_conv_b'][idx], P['rg_w_a'][idx], P['rg_b_a'][idx], P['rg_w_x'][idx],
                                          P['rg_b_x'][idx], P['rg_lambda'][idx], P['rg_w_out'][idx])
            rg_conv.append(c_new)
            rg_h.append(h_new)
        elif kind == 1:
            y, c_new, s_new = ssd_mixer(h, ssd_conv0[idx], ssd_s0[idx], P['ssd_w_in'][idx], P['ssd_conv_w'][idx],
                                        P['ssd_conv_b'][idx], P['ssd_dt_bias'][idx], P['ssd_a_log'][idx],
                                        P['ssd_d'][idx], P['ssd_norm_g'][idx], P['ssd_w_out'][idx])
            ssd_conv.append(c_new)
            ssd_s.append(s_new)
        else:
            y, s_new = hgrn2_mixer(h, hg_s0[idx], lower_bounds[layer], P['hg_w_in'][idx], P['hg_norm_g'][idx],
                                   P['hg_w_out'][idx])
            hg_s.append(s_new)
        x = x + rms_norm(y, g[1])
        h = rms_norm(x, g[2])
        y = memory_cross_attn(h, mem_k[layer], mem_v[layer], P['x_w_q'][layer], P['x_w_o'][layer])
        x = x + rms_norm(y, g[3])
    return x, jnp.stack(rg_conv), jnp.stack(rg_h), jnp.stack(ssd_conv), jnp.stack(ssd_s), jnp.stack(hg_s)


def setup_inputs(seed: int = 0) -> dict:
    key = jax.random.key(seed)
    keys = iter(jax.random.split(key, 48))

    def nrm(shape, scale):
        return scale * jax.random.normal(next(keys), shape, F32)

    def unif(shape, lo, hi):
        return jax.random.uniform(next(keys), shape, F32, lo, hi)

    d_in = D_MODEL ** -0.5
    lam_a = unif((N_A, LRU_WIDTH), 0.9, 0.999) ** (1.0 / LRU_C)
    dt0 = jnp.exp(unif((N_B, SSD_HEADS), float(np.log(1e-3)), float(np.log(1e-1))))
    return {
        'x_prompt': nrm((BATCH, SEQ, D_MODEL), 1.0),
        'x_sample': nrm((DEC_BATCH, DEC_SEQ, D_MODEL), 1.0),
        'mem_prompt': nrm((BATCH, N_MEM, D_MODEL), 1.0),
        'state_rglru_conv': nrm((N_A, DEC_BATCH, CONV_W - 1, LRU_WIDTH), 1.0),
        'state_rglru_h': nrm((N_A, DEC_BATCH, LRU_WIDTH), 0.5),
        'state_ssd_conv': nrm((N_B, DEC_BATCH, CONV_W - 1, SSD_CONV_DIM), 1.0),
        'state_ssd': nrm((N_B, DEC_BATCH, SSD_HEADS, SSD_HEAD_DIM, SSD_STATE), 0.1),
        'state_hgrn': nrm((N_C, DEC_BATCH, HGRN_HEADS, HGRN_KEY_DIM, HGRN_VAL_DIM), 0.3),
        'cache_mem_k': nrm((DEPTH, DEC_BATCH, N_MEM, X_HEADS, X_HEAD_DIM), 1.0),
        'cache_mem_v': nrm((DEPTH, DEC_BATCH, N_MEM, X_HEADS, X_HEAD_DIM), 1.0),
        'norm_g': 1.0 + nrm((DEPTH, 4, D_MODEL), 0.02),
        'mem_norm_g': 1.0 + nrm((DEPTH, D_MODEL), 0.02),
        'rg_w_in': nrm((N_A, D_MODEL, 2 * LRU_WIDTH), d_in),
        'rg_conv_w': nrm((N_A, CONV_W, LRU_WIDTH), CONV_W ** -0.5),
        'rg_conv_b': nrm((N_A, LRU_WIDTH), 0.01),
        'rg_w_a': nrm((N_A, LRU_BLOCKS, LRU_BLOCK, LRU_BLOCK), LRU_BLOCK ** -0.5),
        'rg_b_a': nrm((N_A, LRU_WIDTH), 0.01),
        'rg_w_x': nrm((N_A, LRU_BLOCKS, LRU_BLOCK, LRU_BLOCK), LRU_BLOCK ** -0.5),
        'rg_b_x': nrm((N_A, LRU_WIDTH), 0.01),
        'rg_lambda': jnp.log(lam_a) - jnp.log1p(-lam_a),
        'rg_w_out': nrm((N_A, LRU_WIDTH, D_MODEL), LRU_WIDTH ** -0.5),
        'ssd_w_in': nrm((N_B, D_MODEL, BRANCH + SSD_CONV_DIM + SSD_HEADS), d_in),
        'ssd_conv_w': nrm((N_B, CONV_W, SSD_CONV_DIM), CONV_W ** -0.5),
        'ssd_conv_b': nrm((N_B, SSD_CONV_DIM), 0.01),
        'ssd_dt_bias': dt0 + jnp.log(-jnp.expm1(-dt0)),
        'ssd_a_log': jnp.log(unif((N_B, SSD_HEADS), 1.0, 16.0)),
        'ssd_d': 1.0 + nrm((N_B, SSD_HEADS), 0.02),
        'ssd_norm_g': 1.0 + nrm((N_B, BRANCH), 0.02),
        'ssd_w_out': nrm((N_B, BRANCH, D_MODEL), BRANCH ** -0.5),
        'hg_w_in': nrm((N_C, D_MODEL, 4 * BRANCH), d_in),
        'hg_lower_bounds': nrm((DEPTH, BRANCH), 0.1),
        'hg_norm_g': 1.0 + nrm((N_C, BRANCH), 0.02),
        'hg_w_out': nrm((N_C, BRANCH, D_MODEL), BRANCH ** -0.5),
        'x_w_q': nrm((DEPTH, D_MODEL, D_MODEL), d_in),
        'x_w_k': nrm((DEPTH, D_MODEL, D_MODEL), d_in),
        'x_w_v': nrm((DEPTH, D_MODEL, D_MODEL), d_in),
        'x_w_o': nrm((DEPTH, D_MODEL, D_MODEL), d_in),
    }


def reference(x_prompt, x_sample, mem_prompt, state_rglru_conv, state_rglru_h, state_ssd_conv, state_ssd,
              state_hgrn, cache_mem_k, cache_mem_v, norm_g, mem_norm_g, rg_w_in, rg_conv_w, rg_conv_b, rg_w_a,
              rg_b_a, rg_w_x, rg_b_x, rg_lambda, rg_w_out, ssd_w_in, ssd_conv_w, ssd_conv_b, ssd_dt_bias,
              ssd_a_log, ssd_d, ssd_norm_g, ssd_w_out, hg_w_in, hg_lower_bounds, hg_norm_g, hg_w_out,
              x_w_q, x_w_k, x_w_v, x_w_o):
    P = {
        'norm_g': norm_g, 'rg_w_in': rg_w_in, 'rg_conv_w': rg_conv_w, 'rg_conv_b': rg_conv_b,
        'rg_w_a': rg_w_a, 'rg_b_a': rg_b_a, 'rg_w_x': rg_w_x, 'rg_b_x': rg_b_x, 'rg_lambda': rg_lambda,
        'rg_w_out': rg_w_out, 'ssd_w_in': ssd_w_in, 'ssd_conv_w': ssd_conv_w, 'ssd_conv_b': ssd_conv_b,
        'ssd_dt_bias': ssd_dt_bias, 'ssd_a_log': ssd_a_log, 'ssd_d': ssd_d, 'ssd_norm_g': ssd_norm_g,
        'ssd_w_out': ssd_w_out, 'hg_w_in': hg_w_in, 'hg_lower_bounds': hg_lower_bounds,
        'hg_norm_g': hg_norm_g, 'hg_w_out': hg_w_out, 'x_w_q': x_w_q, 'x_w_o': x_w_o,
    }
    dtype = x_prompt.dtype
    bp = x_prompt.shape[0]
    mem_kv = [memory_kv(mem_prompt, mem_norm_g[l], x_w_k[l], x_w_v[l]) for l in range(DEPTH)]
    new_mem_k_p = jnp.stack([kv[0] for kv in mem_kv])
    new_mem_v_p = jnp.stack([kv[1] for kv in mem_kv])
    y_prompt, rgc_p, rgh_p, sc_p, ss_p, hs_p = run_trunk(
        x_prompt, new_mem_k_p, new_mem_v_p,
        jnp.zeros((N_A, bp, CONV_W - 1, LRU_WIDTH), dtype),
        jnp.zeros((N_A, bp, LRU_WIDTH), dtype),
        jnp.zeros((N_B, bp, CONV_W - 1, SSD_CONV_DIM), dtype),
        jnp.zeros((N_B, bp, SSD_HEADS, SSD_HEAD_DIM, SSD_STATE), dtype),
        jnp.zeros((N_C, bp, HGRN_HEADS, HGRN_KEY_DIM, HGRN_VAL_DIM), dtype),
        P)
    y_sample, rgc_s, rgh_s, sc_s, ss_s, hs_s = run_trunk(
        x_sample, cache_mem_k, cache_mem_v, state_rglru_conv, state_rglru_h, state_ssd_conv, state_ssd,
        state_hgrn, P)
    return (y_prompt, y_sample, rgc_p, rgh_p, sc_p, ss_p, hs_p, new_mem_k_p, new_mem_v_p,
            rgc_s, rgh_s, sc_s, ss_s, hs_s)
```

```cpp
#include <hip/hip_runtime.h>
#include <cstdio>
#include <cstdint>

namespace pg8 {
#define PG8_LAS __attribute__((address_space(3)))
typedef unsigned short bf16_t;
typedef short bf16x8 __attribute__((ext_vector_type(8)));
typedef float f32x4 __attribute__((ext_vector_type(4)));
typedef unsigned u32x4 __attribute__((ext_vector_type(4)));
typedef unsigned u32x2 __attribute__((ext_vector_type(2)));
constexpr int BM = 256, BK = 64, HALF = 128, HTB = HALF * BK * 2, STAGE_BYTES = 8 * HTB, NXCD = 8, WGM = 8;

__host__ __device__ __forceinline__ int lds_byte(int r, int c) { const int st = (r >> 4) * 2 + (c >> 5), rr = r & 15, cc = c & 31, ob = rr * 64 + cc * 2; return st * 1024 + (ob ^ (((ob >> 9) & 1) << 5)); }
__host__ __device__ __forceinline__ void stage_rc(int b, int& R, int& C) { const int st = b / 1024, sb = b % 1024, swz = sb ^ (((sb >> 9) & 1) << 5); R = (st >> 1) * 16 + swz / 64; C = (st & 1) * 32 + (swz % 64) / 2; }
__host__ __device__ __forceinline__ int perm32(int rho) { const int n = rho >> 4, i = rho & 15; return 8 * (i >> 2) + 4 * n + (i & 3); }

struct Unit { int pm, pn; };
struct Gemm { const bf16_t* A; const bf16_t* Bt; int M, N, K, lda, a_shift; };

struct StaticOrder {
    int nM, nN, nwg, G, c;
    __host__ __device__ void init(int M, int N, int G_, int c_) { nM = M / BM; nN = N / BM; nwg = nM * nN; G = G_; c = c_; }
    __host__ __device__ bool next(int i, Unit& u) const {
        const long L = (long)i * G + c; if (L >= nwg) return false;
        int wgid = (int)L; { const int q = nwg / NXCD, r = nwg % NXCD, xcd = wgid % NXCD, off = wgid / NXCD; wgid = (xcd < r ? xcd * (q + 1) : r * (q + 1) + (xcd - r) * q) + off; }
        const int nig = WGM * nN, gid = wgid / nig, fm = gid * WGM, gsz = (nM - fm) < WGM ? (nM - fm) : WGM;
        u.pm = fm + ((wgid % nig) % gsz); u.pn = (wgid % nig) / gsz; return true;
    }
    __device__ __forceinline__ void a_ready(const Unit&) const {}
    __device__ __forceinline__ void done(const Unit&) const {}
};

__device__ __forceinline__ unsigned cvt_pk_bf16(float lo, float hi) { unsigned r; asm volatile("v_cvt_pk_bf16_f32 %0, %1, %2" : "=v"(r) : "v"(lo), "v"(hi)); return r; }

struct EpiF32 {
    static constexpr bool PERM = false, AFTER_DRAIN = false;
    float* C; int ldc;
    __device__ __forceinline__ void operator()(const f32x4 (&acc)[2][2][4][2], const Unit& u, int wr, int wc, int fr, int fq) const {
        const int row0 = u.pm * BM + wr * 64 + fr, col0 = u.pn * BM + wc * 32 + 4 * fq;
#pragma unroll
        for (int ai = 0; ai < 2; ++ai)
#pragma unroll
            for (int m = 0; m < 4; ++m) { float* rowp = C + (size_t)(row0 + ai * HALF + m * 16) * ldc + col0;
#pragma unroll
                for (int bj = 0; bj < 2; ++bj)
#pragma unroll
                    for (int n = 0; n < 2; ++n) *(f32x4*)(rowp + bj * HALF + n * 16) = acc[ai][bj][m][n]; }
    }
};
struct EpiBf16 {
    static constexpr bool PERM = true, AFTER_DRAIN = false;
    bf16_t* O; int ldc;
    __device__ __forceinline__ void operator()(const f32x4 (&acc)[2][2][4][2], const Unit& u, int wr, int wc, int fr, int fq) const {
        const int row0 = u.pm * BM + wr * 64 + fr, col0 = u.pn * BM + wc * 32 + 8 * fq;
#pragma unroll
        for (int ai = 0; ai < 2; ++ai)
#pragma unroll
            for (int m = 0; m < 4; ++m) { bf16_t* rowp = O + (size_t)(row0 + ai * HALF + m * 16) * ldc + col0;
#pragma unroll
                for (int bj = 0; bj < 2; ++bj) { const f32x4 v0 = acc[ai][bj][m][0], v1 = acc[ai][bj][m][1];
                    u32x4 w; w.x = cvt_pk_bf16(v0[0], v0[1]); w.y = cvt_pk_bf16(v0[2], v0[3]); w.z = cvt_pk_bf16(v1[0], v1[1]); w.w = cvt_pk_bf16(v1[2], v1[3]);
                    *(u32x4*)(rowp + bj * HALF) = w; } }
    }
};
struct EpiMemKV {
    static constexpr bool PERM = false, AFTER_DRAIN = false;
    float* outK; float* outV; bf16_t* KP;
    __device__ __forceinline__ void operator()(const f32x4 (&acc)[2][2][4][2], const Unit& u, int wr, int wc, int fr, int fq) const {
        const int kv = u.pn >> 4, layer = (u.pn >> 2) & 3, ct = u.pn & 3;
        const int row0 = u.pm * BM + wr * 64 + fr, col0 = ct * BM + wc * 32 + 4 * fq;
        float* C = (kv ? outV : outK) + (size_t)layer * 2048 * 1024;
        bf16_t* Kb = KP + (size_t)layer * 2048 * 1024;
#pragma unroll
        for (int ai = 0; ai < 2; ++ai)
#pragma unroll
            for (int m = 0; m < 4; ++m) { const size_t off = (size_t)(row0 + ai * HALF + m * 16) * 1024 + col0;
#pragma unroll
                for (int bj = 0; bj < 2; ++bj)
#pragma unroll
                    for (int n = 0; n < 2; ++n) { const f32x4 v = acc[ai][bj][m][n]; *(f32x4*)(C + off + bj * HALF + n * 16) = v;
                        if (kv == 0) { u32x2 w; w.x = cvt_pk_bf16(v[0], v[1]); w.y = cvt_pk_bf16(v[2], v[3]); *(u32x2*)(Kb + off + bj * HALF + n * 16) = w; } } }
    }
};

template <class Epi, class Sched>
__device__ __forceinline__ void gemm_phase(PG8_LAS unsigned char* lds, const Gemm g, const Sched& S, const Epi& E) {
    int tid_ = threadIdx.x; asm volatile("" : "+v"(tid_));
    const int tid = tid_, wid = __builtin_amdgcn_readfirstlane(tid >> 6), lane = tid & 63, wr = wid >> 2, wc = wid & 3, fr = lane & 15, fq = lane >> 4;
    const int K = g.K, nt = K / BK, lda = g.lda;
    unsigned voffA[2], voffB[2];
#pragma unroll
    for (int i = 0; i < 2; ++i) { int R, C; stage_rc(tid * 16 + i * 8192, R, C); const int Rb = Epi::PERM ? ((R & ~31) + perm32(R & 31)) : R;
        voffA[i] = (unsigned)(R * lda + C) * 2u; voffB[i] = (unsigned)(Rb * K + C) * 2u; }
    const size_t kstep = (size_t)(BK * 2);
    const size_t hsA = (size_t)HALF * lda * 2, tsA = 2 * hsA;
    const size_t hsB = (size_t)HALF * K * 2, tsB = 2 * hsB;
    const unsigned ldsw = (unsigned)wid * 1024u;
    const int aoff = lds_byte(wr * 64 + fr, fq * 8), boff = lds_byte(wc * 32 + fr, fq * 8);
#define PG8_SA(b, h) (((b) * 2 + (h)) * HTB)
#define PG8_SB(b, h) ((4 + (b) * 2 + (h)) * HTB)
#define PG8_STAGE(bufoff, gbase, voff) do { _Pragma("unroll") for (int _i = 0; _i < 2; ++_i) \
        __builtin_amdgcn_global_load_lds((const unsigned*)((const char*)(gbase) + (voff)[_i]), (PG8_LAS unsigned*)(lds + (bufoff) + ldsw + _i * 8192), 16, 0, 0); } while (0)
#define PG8_LDA(dst, b, h) do { _Pragma("unroll") for (int m = 0; m < 4; ++m) _Pragma("unroll") for (int k = 0; k < 2; ++k) dst[m][k] = *(const PG8_LAS bf16x8*)(lds + PG8_SA(b, h) + aoff + m * 2048 + k * 1024); } while (0)
#define PG8_LDB(dst, b, h) do { _Pragma("unroll") for (int n = 0; n < 2; ++n) _Pragma("unroll") for (int k = 0; k < 2; ++k) dst[n][k] = *(const PG8_LAS bf16x8*)(lds + PG8_SB(b, h) + boff + n * 2048 + k * 1024); } while (0)
#define PG8_MMA(ai, bj, At, Bt) do { __builtin_amdgcn_s_setprio(1); _Pragma("unroll") for (int m = 0; m < 4; ++m) _Pragma("unroll") for (int n = 0; n < 2; ++n) _Pragma("unroll") for (int k = 0; k < 2; ++k) \
        acc[ai][bj][m][n] = __builtin_amdgcn_mfma_f32_16x16x32_bf16(Bt[n][k], At[m][k], acc[ai][bj][m][n], 0, 0, 0); __builtin_amdgcn_s_setprio(0); } while (0)
#define PG8_WAIT_V(n) asm volatile("s_waitcnt vmcnt(" #n ")" ::: "memory")
#define PG8_WAIT_L(n) asm volatile("s_waitcnt lgkmcnt(" #n ")" ::: "memory")
#define PG8_BAR __builtin_amdgcn_s_barrier()
#define PG8_SCHED __builtin_amdgcn_sched_barrier(0)
#define PG8_ABASE(u) ((const char*)g.A + (size_t)(u).pm * tsA + (g.a_shift >= 0 ? (size_t)((u).pn >> g.a_shift) * 512 : (size_t)0))
    Unit cur, nxt; int ui = 0;
    if (!S.next(0, cur)) return;
    f32x4 acc[2][2][4][2];
#pragma unroll
    for (int a = 0; a < 2; ++a)
#pragma unroll
        for (int b = 0; b < 2; ++b)
#pragma unroll
            for (int m = 0; m < 4; ++m)
#pragma unroll
                for (int n = 0; n < 2; ++n) acc[a][b][m][n] = (f32x4){0.f, 0.f, 0.f, 0.f};
    bf16x8 At[4][2], B0[2][2], B1[2][2];
    const char* cA = PG8_ABASE(cur); const char* cB = (const char*)g.Bt + (size_t)cur.pn * tsB;
    S.a_ready(cur);
    PG8_STAGE(PG8_SB(0, 0), cB, voffB); PG8_STAGE(PG8_SA(0, 0), cA, voffA); PG8_STAGE(PG8_SB(0, 1), cB + hsB, voffB); PG8_STAGE(PG8_SA(0, 1), cA + hsA, voffA);
    if (wr == 1) PG8_BAR;
    PG8_WAIT_V(4); PG8_BAR;
    PG8_STAGE(PG8_SB(1, 0), cB + kstep, voffB); PG8_STAGE(PG8_SA(1, 0), cA + kstep, voffA); PG8_STAGE(PG8_SB(1, 1), cB + hsB + kstep, voffB);
    PG8_WAIT_V(6); PG8_BAR;
    for (;;) {
        const bool has_next = S.next(ui + 1, nxt);
        const char* nA = has_next ? PG8_ABASE(nxt) : cA; const char* nB = has_next ? (const char*)g.Bt + (size_t)nxt.pn * tsB : cB;
        for (int t = 0; t < nt; t += 2) {
            const bool last = (t == nt - 2);
            const char* a1 = cA + (size_t)(t + 1) * kstep;
            const char* a2 = last ? nA : cA + (size_t)(t + 2) * kstep; const char* b2 = last ? nB : cB + (size_t)(t + 2) * kstep;
            const char* a3 = a2 + kstep; const char* b3 = b2 + kstep;
            if (last && has_next) S.a_ready(nxt);
            PG8_LDB(B0, 0, 0); PG8_SCHED; PG8_LDA(At, 0, 0); PG8_STAGE(PG8_SA(1, 1), a1 + hsA, voffA);
            PG8_WAIT_L(8); PG8_BAR; PG8_WAIT_L(0); PG8_MMA(0, 0, At, B0); PG8_BAR; PG8_SCHED;
            PG8_LDB(B1, 0, 1); PG8_STAGE(PG8_SB(0, 0), b2, voffB);
            PG8_BAR; PG8_WAIT_L(0); PG8_MMA(0, 1, At, B1); PG8_BAR;
            PG8_LDA(At, 0, 1); PG8_STAGE(PG8_SA(0, 0), a2, voffA);
            PG8_BAR; PG8_WAIT_L(0); PG8_MMA(1, 0, At, B0); PG8_BAR; PG8_SCHED;
            PG8_STAGE(PG8_SB(0, 1), b2 + hsB, voffB);
            PG8_WAIT_V(6); PG8_BAR; PG8_MMA(1, 1, At, B1); PG8_BAR;
            PG8_LDB(B0, 1, 0); PG8_SCHED; PG8_LDA(At, 1, 0); PG8_STAGE(PG8_SA(0, 1), a2 + hsA, voffA);
            PG8_WAIT_L(8); PG8_BAR; PG8_WAIT_L(0); PG8_MMA(0, 0, At, B0); PG8_BAR; PG8_SCHED;
            PG8_LDB(B1, 1, 1); PG8_STAGE(PG8_SB(1, 0), b3, voffB);
            PG8_BAR; PG8_WAIT_L(0); PG8_MMA(0, 1, At, B1); PG8_BAR;
            PG8_LDA(At, 1, 1); PG8_STAGE(PG8_SA(1, 0), a3, voffA);
            PG8_BAR; PG8_WAIT_L(0); PG8_MMA(1, 0, At, B0); PG8_BAR; PG8_SCHED;
            PG8_STAGE(PG8_SB(1, 1), b3 + hsB, voffB);
            PG8_WAIT_V(6); PG8_BAR; PG8_MMA(1, 1, At, B1); PG8_BAR;
        }
        if constexpr (!Epi::AFTER_DRAIN) { E(acc, cur, wr, wc, fr, fq); S.done(cur); }
        if (!has_next) break;
#pragma unroll
        for (int a = 0; a < 2; ++a)
#pragma unroll
            for (int b = 0; b < 2; ++b)
#pragma unroll
                for (int m = 0; m < 4; ++m)
#pragma unroll
                    for (int n = 0; n < 2; ++n) acc[a][b][m][n] = (f32x4){0.f, 0.f, 0.f, 0.f};
        cur = nxt; cA = nA; cB = nB; ++ui;
    }
    PG8_WAIT_V(0);
    if (wr == 0) PG8_BAR;
    PG8_BAR;
#undef PG8_ABASE
#undef PG8_SA
#undef PG8_SB
#undef PG8_STAGE
#undef PG8_LDA
#undef PG8_LDB
#undef PG8_MMA
#undef PG8_WAIT_V
#undef PG8_WAIT_L
#undef PG8_BAR
#undef PG8_SCHED
}
}

constexpr int NWAVES = 8, NTHR = 512;
constexpr int DM = 1024, BP = 8, LP = 2048, BS = 128, LS = 8, NMEM = 256, DEPTH = 4;
constexpr int MP = BP * LP, MS = BS * LS, MT = MP + MS;
constexpr int BR = 2048;
constexpr int SSD_CONV = 4096, SSD_NIN = 6176, SSD_NPAD = 6400, SSD_H = 32, SSD_P = 64, SSD_N = 128;
constexpr int HG_H = 16, HG_DK = 128, HG_DV = 128;
constexpr float EPS = 1e-6f;

constexpr size_t O_YP = 0;
constexpr size_t O_YS = O_YP + (size_t)MP * DM;
constexpr size_t O_RGCP = O_YS + (size_t)MS * DM;
constexpr size_t O_RGHP = O_RGCP + (size_t)2 * BP * 3 * BR;
constexpr size_t O_SCP = O_RGHP + (size_t)2 * BP * BR;
constexpr size_t O_SSP = O_SCP + (size_t)BP * 3 * SSD_CONV;
constexpr size_t O_HSP = O_SSP + (size_t)BP * SSD_H * SSD_P * SSD_N;
constexpr size_t O_MKP = O_HSP + (size_t)BP * HG_H * HG_DK * HG_DV;
constexpr size_t O_MVP = O_MKP + (size_t)DEPTH * BP * NMEM * DM;
constexpr size_t O_RGCS = O_MVP + (size_t)DEPTH * BP * NMEM * DM;
constexpr size_t O_RGHS = O_RGCS + (size_t)2 * BS * 3 * BR;
constexpr size_t O_SCS = O_RGHS + (size_t)2 * BS * BR;
constexpr size_t O_SSS = O_SCS + (size_t)BS * 3 * SSD_CONV;
constexpr size_t O_HSS = O_SSS + (size_t)BS * SSD_H * SSD_P * SSD_N;
constexpr size_t O_END = O_HSS + (size_t)BS * HG_H * HG_DK * HG_DV;
static_assert(O_END == 109805568ull, "output size");

enum { I_XP = 0, I_XS, I_MEM, I_ST_RGC, I_ST_RGH, I_ST_SC, I_ST_SS, I_ST_HG, I_CK, I_CV, I_NG, I_MNG, I_RG_WIN, I_RG_CW, I_RG_CB, I_RG_WA, I_RG_BA, I_RG_WX, I_RG_BX,
       I_RG_LAM, I_RG_WOUT, I_SSD_WIN, I_SSD_CW, I_SSD_CB, I_SSD_DTB, I_SSD_ALOG, I_SSD_D, I_SSD_NG, I_SSD_WOUT, I_HG_WIN, I_HG_LB, I_HG_NG, I_HG_WOUT, I_XWQ, I_XWK, I_XWV, I_XWO, N_IN };

constexpr size_t MiB = 1u << 20;
constexpr size_t WS_CTL = 0, CTL_ZERO_BYTES = 1 * MiB;
constexpr size_t WS_LB = 1 * MiB;
constexpr size_t WS_CA = 2 * MiB, WS_CB = 4 * MiB;
constexpr size_t WS_WMEM = 8 * MiB;
constexpr size_t WS_RGWIN = WS_WMEM + 16 * MiB;
constexpr size_t WS_RGWAX = WS_RGWIN + 16 * MiB;
constexpr size_t WS_RGWOUT = WS_RGWAX + 4 * MiB;
constexpr size_t WS_SSDWIN = WS_RGWOUT + 8 * MiB;
constexpr size_t WS_SSDWOUT = WS_SSDWIN + 13 * MiB;
constexpr size_t WS_HGWIN = WS_SSDWOUT + 4 * MiB;
constexpr size_t WS_HGWOUT = WS_HGWIN + 16 * MiB;
constexpr size_t WS_XWQ = WS_HGWOUT + 4 * MiB;
constexpr size_t WS_XWO = WS_XWQ + 8 * MiB;
constexpr size_t WS_XN = 128 * MiB;
constexpr size_t WS_P = WS_XN + 36 * MiB;
constexpr size_t WS_HGB = WS_P + 288 * MiB;
constexpr size_t WS_Y = WS_HGB + 72 * MiB;
constexpr size_t WS_Q = WS_Y + 72 * MiB;
constexpr size_t WS_OA = WS_Q + 36 * MiB;
constexpr size_t WS_MEMN = WS_OA + 36 * MiB;
constexpr size_t WS_KP = WS_MEMN + 4 * MiB;
constexpr size_t WS_VT = WS_KP + 16 * MiB;
constexpr size_t WS_T1 = WS_VT + 16 * MiB;
constexpr size_t WS_T2 = WS_T1 + 144 * MiB;
constexpr size_t WS_DT = WS_T2 + 144 * MiB;
constexpr size_t WS_END = WS_DT + 4 * MiB;
static_assert(WS_XWO + 8 * MiB <= WS_XN, "weights region");

constexpr int RING_BYTES = 131072;
constexpr int LDSCTL_OFF = RING_BYTES, MISC_OFF = LDSCTL_OFF + 320;
constexpr int LDS_BYTES = 147456;

#define GAS __attribute__((address_space(1)))
#define LAS __attribute__((address_space(3)))
typedef unsigned short bf16;
typedef unsigned v4u __attribute__((ext_vector_type(4)));
typedef unsigned v2u __attribute__((ext_vector_type(2)));
typedef float f32x4 __attribute__((ext_vector_type(4)));
typedef short bf16x8 __attribute__((ext_vector_type(8)));
typedef GAS unsigned gu32;
#define RLX_AGENT __ATOMIC_RELAXED, __HIP_MEMORY_SCOPE_AGENT
#define LDS_WAIT() asm volatile("s_waitcnt lgkmcnt(0)" ::: "memory")
#define VM_WAIT() asm volatile("s_waitcnt vmcnt(0)" ::: "memory")

__device__ __forceinline__ unsigned f2bf(float f) { unsigned u = __builtin_bit_cast(unsigned, f); return (u + 0x7fffu + ((u >> 16) & 1u)) >> 16; }
__device__ __forceinline__ unsigned pk2(float lo, float hi) { return f2bf(lo) | (f2bf(hi) << 16); }
__device__ __forceinline__ float bflo(unsigned w) { return __builtin_bit_cast(float, w << 16); }
__device__ __forceinline__ float bfhi(unsigned w) { return __builtin_bit_cast(float, w & 0xffff0000u); }
__device__ __forceinline__ float bf2f(bf16 v) { return __builtin_bit_cast(float, (unsigned)v << 16); }
__device__ __forceinline__ void unpack8(const v4u w, float (&f)[8]) { f[0] = bflo(w.x); f[1] = bfhi(w.x); f[2] = bflo(w.y); f[3] = bfhi(w.y); f[4] = bflo(w.z); f[5] = bfhi(w.z); f[6] = bflo(w.w); f[7] = bfhi(w.w); }
__device__ __forceinline__ v4u pack8(const float (&f)[8]) { v4u w; w.x = pk2(f[0], f[1]); w.y = pk2(f[2], f[3]); w.z = pk2(f[4], f[5]); w.w = pk2(f[6], f[7]); return w; }
__device__ __forceinline__ float sigmoid_f(float x) { return 1.0f / (1.0f + __expf(-x)); }
__device__ __forceinline__ float silu_f(float x) { return x / (1.0f + __expf(-x)); }
__device__ __forceinline__ float softplus_f(float x) { return x > 20.f ? x : log1pf(expf(x)); }

#define XB_TMO      128
#define XB_XCNT(j)  (256  + 64 * (j))
#define XB_XSUB(j)  (1280 + 64 * (j))
#define XB_XGEN(j)  (2304 + 64 * (j))
#define XB_TOP      3328
#define XB_TOPGEN   3392
#define XCD_BAR_WORDS 3456
#define XB_SPIN_CAP (1u << 18)

__device__ __forceinline__ unsigned xb_ld(unsigned* p)              { return __hip_atomic_load(p, __ATOMIC_RELAXED, __HIP_MEMORY_SCOPE_AGENT); }
__device__ __forceinline__ unsigned xb_add(unsigned* p, unsigned v) { return __hip_atomic_fetch_add(p, v, __ATOMIC_RELAXED, __HIP_MEMORY_SCOPE_AGENT); }
__device__ __forceinline__ unsigned xb_xcc_id() { return (unsigned)__builtin_amdgcn_s_getreg((3 << 11) | 20) & 0xFu; }
#define XB_SPIN(cond, bar) do { unsigned _sp = 0; while (cond) { __builtin_amdgcn_s_sleep(1); \
    if ((++_sp & 255u) == 0u) { if (xb_ld(&(bar)[XB_TMO])) break; if (_sp > XB_SPIN_CAP) { atomicAdd(&(bar)[XB_TMO], 1u); break; } } } } while (0)

struct XcdBarrier { unsigned* bar; unsigned x; volatile LAS unsigned* st; };

__device__ __forceinline__ XcdBarrier xcd_barrier_post(unsigned* bar, volatile LAS unsigned* st) {
    XcdBarrier b; b.bar = bar; b.x = xb_xcc_id(); b.st = st;
    if (threadIdx.x == 0) (void)xb_add(&bar[XB_XCNT(b.x)], 1u);
    return b;
}
__device__ __forceinline__ void xcd_barrier_complete(unsigned* bar, unsigned x, unsigned& nloc, unsigned& nx) {
    const unsigned G = gridDim.x * gridDim.y * gridDim.z;
    unsigned sum, cnt, mine, sp = 0u;
    for (;;) {
        sum = 0u; cnt = 0u; mine = 0u;
#pragma unroll
        for (unsigned j = 0; j < 16; ++j) { const unsigned c = xb_ld(&bar[XB_XCNT(j)]); sum += c; cnt += (c > 0u) ? 1u : 0u; mine = (j == x) ? c : mine; }
        if (sum == G) break;
        __builtin_amdgcn_s_sleep(1);
        if ((++sp & 255u) == 0u) { if (xb_ld(&bar[XB_TMO])) break; if (sp > XB_SPIN_CAP) { atomicAdd(&bar[XB_TMO], 1u); break; } }
    }
    nloc = mine > 0u ? mine : 1u; nx = cnt > 0u ? cnt : 1u;
}
__device__ __forceinline__ void xcd_barrier(const XcdBarrier& b) {
    asm volatile("s_waitcnt vmcnt(0)" ::: "memory");
    __syncthreads();
    if (threadIdx.x == 0) {
        unsigned* bar = b.bar;
        __builtin_amdgcn_s_waitcnt(0);
        unsigned nloc = b.st[0], nx = b.st[1];
        if (nloc == 0u) { xcd_barrier_complete(bar, b.x, nloc, nx); b.st[0] = nloc; b.st[1] = nx; }
        const unsigned old = xb_add(&bar[XB_XSUB(b.x)], 1u);
        const unsigned gen = old / nloc;
        if (old + 1u == (gen + 1u) * nloc) {
            __builtin_amdgcn_fence(__ATOMIC_RELEASE, "agent");
            asm volatile("s_waitcnt vmcnt(0)" ::: "memory");
            const unsigned og = xb_add(&bar[XB_TOP], 1u);
            const unsigned tg = og / nx;
            if (og + 1u == (tg + 1u) * nx) xb_add(&bar[XB_TOPGEN], 1u);
            else XB_SPIN(xb_ld(&bar[XB_TOPGEN]) == tg, bar);
            __builtin_amdgcn_fence(__ATOMIC_ACQUIRE, "agent");
            xb_add(&bar[XB_XGEN(b.x)], 1u);
            asm volatile("s_waitcnt vmcnt(0)" ::: "memory");
        } else {
            XB_SPIN(xb_ld(&bar[XB_XGEN(b.x)]) == gen, bar);
            __builtin_amdgcn_fence(__ATOMIC_ACQUIRE, "agent");
            asm volatile("s_waitcnt vmcnt(0)" ::: "memory");
        }
    }
    __syncthreads();
}

struct WDesc { const float* src; const float* gain; bf16* dst; int K, N; float scale; int item0; };
constexpr int NWD = 56;
struct Args { const float* in[N_IN]; float* out; unsigned char* ws; WDesc wd[NWD]; int nitems; int pad; };

struct Frame {
    LAS unsigned char* lds;
    int tid, lane, wave;
    int vcu, G;
    int gw, NGW;
    int gt, NGT;
};

__device__ __forceinline__ float wave_sum(float v) {
#pragma unroll
    for (int o = 1; o < 64; o <<= 1) v += __shfl_xor(v, o);
    return v;
}

__device__ __forceinline__ void p0_transpose_item(const WDesc& d, LAS float* scr, int item, int lane) {
    const int K = d.K, N = d.N;
    const int nblk = N / 32, kb = item / nblk, nb = item % nblk, k0 = 64 * kb, n0 = 32 * nb;
    const float* W = d.src;
#pragma unroll 8
    for (int i = 0; i < 32; ++i) { const int kk = 2 * i + (lane >> 5); const float gsc = (d.gain ? d.gain[k0 + kk] : 1.0f) * d.scale;
        scr[kk * 33 + (lane & 31)] = W[(size_t)(k0 + kk) * N + n0 + (lane & 31)] * gsc; }
    LDS_WAIT(); asm volatile("" ::: "memory");
    const int c = lane & 7;
#pragma unroll
    for (int j = 0; j < 4; ++j) { const int n = (lane >> 3) + 8 * j; const LAS float* s = scr + (8 * c) * 33 + n;
        v4u o; o.x = pk2(s[0 * 33], s[1 * 33]); o.y = pk2(s[2 * 33], s[3 * 33]); o.z = pk2(s[4 * 33], s[5 * 33]); o.w = pk2(s[6 * 33], s[7 * 33]);
        *(GAS v4u*)(d.dst + (size_t)(n0 + n) * K + k0 + 8 * c) = o; }
    LDS_WAIT(); asm volatile("" ::: "memory");
}
__device__ __forceinline__ void rms_row_to_bf16(int lane, const float* xrow, bf16* orow, float* copy) {
    const GAS f32x4* xr = (const GAS f32x4*)xrow + lane;
    f32x4 v[4]; float s = 0.f;
#pragma unroll
    for (int j = 0; j < 4; ++j) { v[j] = xr[64 * j]; s += (v[j].x * v[j].x + v[j].y * v[j].y) + (v[j].z * v[j].z + v[j].w * v[j].w); }
    const float rstd = 1.0f / sqrtf(wave_sum(s) * (1.f / DM) + EPS);
    if (copy) { GAS f32x4* c4 = (GAS f32x4*)copy + lane;
#pragma unroll
        for (int j = 0; j < 4; ++j) c4[64 * j] = v[j]; }
    GAS v2u* o8 = (GAS v2u*)orow + lane;
#pragma unroll
    for (int j = 0; j < 4; ++j) { v2u w; w.x = pk2(v[j].x * rstd, v[j].y * rstd); w.y = pk2(v[j].z * rstd, v[j].w * rstd); o8[64 * j] = w; }
}

__device__ __forceinline__ void p0_prologue(const Frame& F, const __attribute__((address_space(4))) Args* ap) {
    const __attribute__((address_space(4))) Args& a = *ap;
    LAS float* scr = (LAS float*)(F.lds + F.wave * 16384);
    for (int it = F.gw; it < a.nitems; it += F.NGW) {
        int di = 0;
#pragma unroll 1
        for (int j = 1; j < NWD; ++j) if (it >= a.wd[j].item0) di = j;
        WDesc d; d.src = a.wd[di].src; d.gain = a.wd[di].gain; d.dst = a.wd[di].dst; d.K = a.wd[di].K; d.N = a.wd[di].N; d.scale = a.wd[di].scale; d.item0 = a.wd[di].item0;
        p0_transpose_item(d, scr, it - d.item0, F.lane);
    }
    { GAS v4u* z = (GAS v4u*)(a.ws + WS_SSDWIN + (size_t)SSD_NIN * DM * 2); const int nz = (SSD_NPAD - SSD_NIN) * DM * 2 / 16;
      for (int i = F.gt; i < nz; i += F.NGT) z[i] = (v4u){0u, 0u, 0u, 0u}; }
    { const float* lbp = a.in[I_HG_LB]; float* LB = (float*)(a.ws + WS_LB);
      for (int c = F.gt; c < BR; c += F.NGT) { const float v0 = lbp[c], v1 = lbp[BR + c], v2 = lbp[2 * BR + c], v3 = lbp[3 * BR + c];
          const float mx = fmaxf(fmaxf(v0, v1), fmaxf(v2, v3)); const float e0 = expf(v0 - mx), e1 = expf(v1 - mx), e2 = expf(v2 - mx), e3 = expf(v3 - mx); const float inv = 1.0f / (e0 + e1 + e2 + e3);
          LB[c] = 0.f; LB[BR + c] = e1 * inv; LB[2 * BR + c] = (e1 + e2) * inv; LB[3 * BR + c] = (e1 + e2 + e3) * inv; } }
    bf16* XN = (bf16*)(a.ws + WS_XN);
    for (int r = F.gw; r < MT; r += F.NGW) { const float* src = r < MP ? a.in[I_XP] + (size_t)r * DM : a.in[I_XS] + (size_t)(r - MP) * DM;
        rms_row_to_bf16(F.lane, src, XN + (size_t)r * DM, a.out + (size_t)r * DM); }
    bf16* MEMN = (bf16*)(a.ws + WS_MEMN);
    for (int r = F.gw; r < BP * NMEM; r += F.NGW) rms_row_to_bf16(F.lane, a.in[I_MEM] + (size_t)r * DM, MEMN + (size_t)r * DM, nullptr);
}

__device__ __forceinline__ void thin_pass(const Frame& F, const float* Y, float* X, bf16* XN, const float* g, bool write_xn) {
    f32x4 gv[4];
#pragma unroll
    for (int j = 0; j < 4; ++j) gv[j] = ((const GAS f32x4*)g)[64 * j + F.lane];
    for (int r = F.gw; r < MT; r += F.NGW) {
        const GAS f32x4* yr = (const GAS f32x4*)(Y + (size_t)r * DM) + F.lane;
        GAS f32x4* xr = (GAS f32x4*)(X + (size_t)r * DM) + F.lane;
        f32x4 y[4], x[4]; float s = 0.f;
#pragma unroll
        for (int j = 0; j < 4; ++j) { y[j] = yr[64 * j]; x[j] = xr[64 * j]; s += (y[j].x * y[j].x + y[j].y * y[j].y) + (y[j].z * y[j].z + y[j].w * y[j].w); }
        const float rstd = 1.0f / sqrtf(wave_sum(s) * (1.f / DM) + EPS);
        float s2 = 0.f;
#pragma unroll
        for (int j = 0; j < 4; ++j) { x[j] = x[j] + y[j] * rstd * gv[j]; s2 += (x[j].x * x[j].x + x[j].y * x[j].y) + (x[j].z * x[j].z + x[j].w * x[j].w); xr[64 * j] = x[j]; }
        if (write_xn) {
            const float rstd2 = 1.0f / sqrtf(wave_sum(s2) * (1.f / DM) + EPS);
            GAS v2u* o8 = (GAS v2u*)(XN + (size_t)r * DM) + F.lane;
#pragma unroll
            for (int j = 0; j < 4; ++j) { v2u w; w.x = pk2(x[j].x * rstd2, x[j].y * rstd2); w.y = pk2(x[j].z * rstd2, x[j].w * rstd2); o8[64 * j] = w; }
        }
    }
}

struct RowInfo { int sample, b, t, L; };
__device__ __forceinline__ RowInfo row_info(int r) { RowInfo i; if (r < MP) { i.sample = 0; i.b = r >> 11; i.t = r & 2047; i.L = LP; } else { const int rr = r - MP; i.sample = 1; i.b = rr >> 3; i.t = rr & 7; i.L = LS; } return i; }

template <bool SILU>
__device__ __forceinline__ void conv_phase(const Frame& F, const bf16* P, int ldp, int col0, int C, const float* state, const float* w, const float* bias, bf16* OUT, float* outp, float* outs) {
    const int cv = C / 8; const int total = MT * cv;
    for (int it = F.gt; it < total; it += F.NGT) {
        const int r = it / cv, c = (it - r * cv) * 8; const RowInfo ri = row_info(r);
        float u[4][8];
        unpack8(*(const GAS v4u*)(P + (size_t)r * ldp + col0 + c), u[0]);
#pragma unroll
        for (int k = 1; k < 4; ++k) {
            if (ri.t - k >= 0) unpack8(*(const GAS v4u*)(P + (size_t)(r - k) * ldp + col0 + c), u[k]);
            else if (ri.sample) { const float* sp = state + ((size_t)ri.b * 3 + (3 + ri.t - k)) * C + c; const f32x4 s0 = *(const GAS f32x4*)sp, s1 = *(const GAS f32x4*)(sp + 4);
                u[k][0] = s0.x; u[k][1] = s0.y; u[k][2] = s0.z; u[k][3] = s0.w; u[k][4] = s1.x; u[k][5] = s1.y; u[k][6] = s1.z; u[k][7] = s1.w; }
            else {
#pragma unroll
                for (int e = 0; e < 8; ++e) u[k][e] = 0.f; }
        }
        float o[8];
#pragma unroll
        for (int e = 0; e < 8; ++e) { float v = bias[c + e] + w[0 * C + c + e] * u[3][e] + w[1 * C + c + e] * u[2][e] + w[2 * C + c + e] * u[1][e] + w[3 * C + c + e] * u[0][e]; o[e] = SILU ? silu_f(v) : v; }
        *(GAS v4u*)(OUT + (size_t)r * C + c) = pack8(o);
        if (ri.t >= ri.L - 3) { float* dst = (ri.sample ? outs : outp) + ((size_t)ri.b * 3 + (ri.t - (ri.L - 3))) * C + c;
            *(GAS f32x4*)dst = (f32x4){u[0][0], u[0][1], u[0][2], u[0][3]}; *(GAS f32x4*)(dst + 4) = (f32x4){u[0][4], u[0][5], u[0][6], u[0][7]}; }
    }
}

struct RgPar { const bf16* UC; const bf16* RI; const bf16* P; const float* ba; const float* bx; const float* lam; };
__device__ __forceinline__ void rg_ab(const RgPar& p, int r, int c, const float (&sp)[4], const float (&ba)[4], const float (&bx)[4], float (&a)[4], float (&bb)[4]) {
    const int blk = c >> 8, cc = c & 255;
    const v2u uw = *(const GAS v2u*)(p.UC + (size_t)r * BR + c);
    const v2u aw = *(const GAS v2u*)(p.RI + (size_t)r * 4096 + blk * 512 + cc);
    const v2u xw = *(const GAS v2u*)(p.RI + (size_t)r * 4096 + blk * 512 + 256 + cc);
    const float u[4] = {bflo(uw.x), bfhi(uw.x), bflo(uw.y), bfhi(uw.y)};
    const float la[4] = {bflo(aw.x), bfhi(aw.x), bflo(aw.y), bfhi(aw.y)};
    const float lx[4] = {bflo(xw.x), bfhi(xw.x), bflo(xw.y), bfhi(xw.y)};
#pragma unroll
    for (int e = 0; e < 4; ++e) { const float rr = sigmoid_f(la[e] + ba[e]), ii = sigmoid_f(lx[e] + bx[e]); const float log_a = -8.0f * rr * sp[e];
        a[e] = expf(log_a); bb[e] = sqrtf(-expm1f(2.0f * log_a)) * (ii * u[e]); }
}
__device__ __forceinline__ void rg_scan_a(const Frame& F, const RgPar& p, float* CA, float* CB) {
    for (int it = F.gt; it < BP * 32 * 512; it += F.NGT) {
        const int c = (it & 511) * 4, ch = (it >> 9) & 31, b = it >> 14;
        float sp[4], ba[4], bx[4];
#pragma unroll
        for (int e = 0; e < 4; ++e) { sp[e] = softplus_f(-p.lam[c + e]); ba[e] = p.ba[c + e]; bx[e] = p.bx[c + e]; }
        float A[4] = {1.f, 1.f, 1.f, 1.f}, H[4] = {0.f, 0.f, 0.f, 0.f};
        const int r0 = b * LP + ch * 64;
        for (int t = 0; t < 64; ++t) { float a[4], bb[4]; rg_ab(p, r0 + t, c, sp, ba, bx, a, bb);
#pragma unroll
            for (int e = 0; e < 4; ++e) { H[e] = a[e] * H[e] + bb[e]; A[e] *= a[e]; } }
        const size_t o = ((size_t)(b * 32 + ch)) * BR + c;
        *(GAS f32x4*)(CA + o) = (f32x4){A[0], A[1], A[2], A[3]}; *(GAS f32x4*)(CB + o) = (f32x4){H[0], H[1], H[2], H[3]};
    }
}
__device__ __forceinline__ void rg_scan_b(const Frame& F, const RgPar& p, const float* CA, const float* CB, const float* h0s, bf16* HG, float* outp, float* outs) {
    const int NP = BP * 32 * 512, NS = BS * 512;
    for (int it = F.gt; it < NP + NS; it += F.NGT) {
        int c, r0, nt; float H[4]; float* fin;
        if (it < NP) { c = (it & 511) * 4; const int ch = (it >> 9) & 31, b = it >> 14; r0 = b * LP + ch * 64; nt = 64;
            H[0] = H[1] = H[2] = H[3] = 0.f;
            for (int j = 0; j < ch; ++j) { const size_t o = ((size_t)(b * 32 + j)) * BR + c; const f32x4 Aj = *(const GAS f32x4*)(CA + o), Bj = *(const GAS f32x4*)(CB + o);
                H[0] = Aj.x * H[0] + Bj.x; H[1] = Aj.y * H[1] + Bj.y; H[2] = Aj.z * H[2] + Bj.z; H[3] = Aj.w * H[3] + Bj.w; }
            fin = (ch == 31) ? outp + (size_t)b * BR + c : nullptr;
        } else { const int is = it - NP; c = (is & 511) * 4; const int b = is >> 9; r0 = MP + b * LS; nt = LS;
            const f32x4 h0 = *(const GAS f32x4*)(h0s + (size_t)b * BR + c); H[0] = h0.x; H[1] = h0.y; H[2] = h0.z; H[3] = h0.w;
            fin = outs + (size_t)b * BR + c; }
        float sp[4], ba[4], bx[4];
#pragma unroll
        for (int e = 0; e < 4; ++e) { sp[e] = softplus_f(-p.lam[c + e]); ba[e] = p.ba[c + e]; bx[e] = p.bx[c + e]; }
        for (int t = 0; t < nt; ++t) { float a[4], bb[4]; const int r = r0 + t; rg_ab(p, r, c, sp, ba, bx, a, bb);
            const v2u gw = *(const GAS v2u*)(p.P + (size_t)r * 4096 + 2048 + c);
            const float gt[4] = {bflo(gw.x), bfhi(gw.x), bflo(gw.y), bfhi(gw.y)};
            float o[4];
#pragma unroll
            for (int e = 0; e < 4; ++e) { H[e] = a[e] * H[e] + bb[e]; o[e] = H[e] * silu_f(gt[e]); }
            v2u w; w.x = pk2(o[0], o[1]); w.y = pk2(o[2], o[3]); *(GAS v2u*)(HG + (size_t)r * BR + c) = w; }
        if (fin) *(GAS f32x4*)fin = (f32x4){H[0], H[1], H[2], H[3]};
    }
}

__device__ __forceinline__ void ssd_dt_phase(const Frame& F, const bf16* P, const float* dt_bias, float* DT) {
    for (int it = F.gt; it < MT * SSD_H; it += F.NGT) { const int r = it >> 5, h = it & 31; DT[it] = softplus_f(bf2f(P[(size_t)r * SSD_NPAD + 6144 + h]) + dt_bias[h]); }
}
__device__ __forceinline__ void ssd_scan(const Frame& F, const bf16* XBC, const bf16* P, const float* DT, const float* a_log, const float* dsk, const float* s0s, float* YG, float* outp, float* outs) {
    LAS float* Bs = (LAS float*)F.lds;
    LAS float* Cs = Bs + 64 * 128;
    LAS float* Xs = Cs + 64 * 128;
    LAS float* Ys = Xs + 64 * 64;
    LAS float* dts = Ys + 64 * 64;
    LAS float* dAs = dts + 64;
    const int tid = F.tid, p = tid >> 3, nq = tid & 7;
    for (int ui = blockIdx.x; ui < 256 + BS * SSD_H; ui += F.G) {
        int b, h, L, row0; float* sdst; float S[4][4];
        if (ui < 256) { b = ui >> 5; h = ui & 31; L = LP; row0 = b * LP; sdst = outp + ((size_t)(b * SSD_H + h) * SSD_P + p) * SSD_N;
#pragma unroll
            for (int i = 0; i < 4; ++i)
#pragma unroll
                for (int e = 0; e < 4; ++e) S[i][e] = 0.f;
        } else { const int su = ui - 256; b = su >> 5; h = su & 31; L = LS; row0 = MP + b * LS; sdst = outs + ((size_t)(b * SSD_H + h) * SSD_P + p) * SSD_N;
            const float* sp = s0s + ((size_t)(b * SSD_H + h) * SSD_P + p) * SSD_N;
#pragma unroll
            for (int i = 0; i < 4; ++i) { const f32x4 v = *(const GAS f32x4*)(sp + 32 * i + 4 * nq); S[i][0] = v.x; S[i][1] = v.y; S[i][2] = v.z; S[i][3] = v.w; }
        }
        const int g = h >> 2; const float ah = -expf(a_log[h]); const float Dh = dsk[h];
        for (int c0 = 0; c0 < L; c0 += 64) {
            const int tn = (L - c0) < 64 ? (L - c0) : 64;
#pragma unroll
            for (int i = 0; i < 2; ++i) { const int item = tid + 512 * i, t = item >> 4, v = item & 15;
                if (t < tn) { const size_t ro = (size_t)(row0 + c0 + t) * SSD_CONV; float f[8];
                    unpack8(*(const GAS v4u*)(XBC + ro + 2048 + g * 128 + 8 * v), f); *(LAS f32x4*)(Bs + t * 128 + 8 * v) = (f32x4){f[0], f[1], f[2], f[3]}; *(LAS f32x4*)(Bs + t * 128 + 8 * v + 4) = (f32x4){f[4], f[5], f[6], f[7]};
                    unpack8(*(const GAS v4u*)(XBC + ro + 3072 + g * 128 + 8 * v), f); *(LAS f32x4*)(Cs + t * 128 + 8 * v) = (f32x4){f[0], f[1], f[2], f[3]}; *(LAS f32x4*)(Cs + t * 128 + 8 * v + 4) = (f32x4){f[4], f[5], f[6], f[7]}; } }
            { const int t = tid >> 3, v = tid & 7;
              if (t < tn) { float f[8]; unpack8(*(const GAS v4u*)(XBC + (size_t)(row0 + c0 + t) * SSD_CONV + h * 64 + 8 * v), f);
                  *(LAS f32x4*)(Xs + t * 64 + 8 * v) = (f32x4){f[0], f[1], f[2], f[3]}; *(LAS f32x4*)(Xs + t * 64 + 8 * v + 4) = (f32x4){f[4], f[5], f[6], f[7]}; } }
            if (tid < tn) { const float d = DT[(size_t)(row0 + c0 + tid) * SSD_H + h]; dts[tid] = d; dAs[tid] = expf(d * ah); }
            __syncthreads();
            for (int t = 0; t < tn; ++t) {
                const float dA = dAs[t], xdt = Xs[t * 64 + p] * dts[t];
                float acc = 0.f;
#pragma unroll
                for (int i = 0; i < 4; ++i) { const f32x4 bv = *(const LAS f32x4*)(Bs + t * 128 + 32 * i + 4 * nq), cv = *(const LAS f32x4*)(Cs + t * 128 + 32 * i + 4 * nq);
                    S[i][0] = dA * S[i][0] + xdt * bv.x; S[i][1] = dA * S[i][1] + xdt * bv.y; S[i][2] = dA * S[i][2] + xdt * bv.z; S[i][3] = dA * S[i][3] + xdt * bv.w;
                    acc += (S[i][0] * cv.x + S[i][1] * cv.y) + (S[i][2] * cv.z + S[i][3] * cv.w); }
                acc += __shfl_xor(acc, 1); acc += __shfl_xor(acc, 2); acc += __shfl_xor(acc, 4);
                if (nq == 0) Ys[t * 64 + p] = acc;
            }
            __syncthreads();
            { const int t = tid >> 3, v = tid & 7;
              if (t < tn) { const size_t r = (size_t)(row0 + c0 + t); float z[8]; unpack8(*(const GAS v4u*)(P + r * SSD_NPAD + h * 64 + 8 * v), z);
                  const f32x4 y0 = *(const LAS f32x4*)(Ys + t * 64 + 8 * v), y1 = *(const LAS f32x4*)(Ys + t * 64 + 8 * v + 4);
                  const f32x4 x0 = *(const LAS f32x4*)(Xs + t * 64 + 8 * v), x1 = *(const LAS f32x4*)(Xs + t * 64 + 8 * v + 4);
                  f32x4 o0, o1;
                  o0.x = (y0.x + Dh * x0.x) * silu_f(z[0]); o0.y = (y0.y + Dh * x0.y) * silu_f(z[1]); o0.z = (y0.z + Dh * x0.z) * silu_f(z[2]); o0.w = (y0.w + Dh * x0.w) * silu_f(z[3]);
                  o1.x = (y1.x + Dh * x1.x) * silu_f(z[4]); o1.y = (y1.y + Dh * x1.y) * silu_f(z[5]); o1.z = (y1.z + Dh * x1.z) * silu_f(z[6]); o1.w = (y1.w + Dh * x1.w) * silu_f(z[7]);
                  float* yo = YG + r * BR + h * 64 + 8 * v; *(GAS f32x4*)yo = o0; *(GAS f32x4*)(yo + 4) = o1; } }
            __syncthreads();
        }
#pragma unroll
        for (int i = 0; i < 4; ++i) *(GAS f32x4*)(sdst + 32 * i + 4 * nq) = (f32x4){S[i][0], S[i][1], S[i][2], S[i][3]};
    }
}
__device__ __forceinline__ void ssd_norm(const Frame& F, const float* YG, bf16* HG) {
    for (int r = F.gw; r < MT; r += F.NGW) {
        const GAS f32x4* yr = (const GAS f32x4*)(YG + (size_t)r * BR) + F.lane; GAS v2u* o8 = (GAS v2u*)(HG + (size_t)r * BR) + F.lane;
#pragma unroll
        for (int j = 0; j < 8; ++j) { const f32x4 v = yr[64 * j]; const float s = wave_sum((v.x * v.x + v.y * v.y) + (v.z * v.z + v.w * v.w)); const float rstd = 1.0f / sqrtf(s * (1.f / 256.f) + EPS);
            v2u w; w.x = pk2(v.x * rstd, v.y * rstd); w.y = pk2(v.z * rstd, v.w * rstd); o8[64 * j] = w; }
    }
}

__device__ __forceinline__ void hgrn_scan(const Frame& F, const bf16* P, const float* LBl, const float* s0s, float* OH, float* outp, float* outs) {
    LAS float* Fs = (LAS float*)F.lds;
    LAS float* Ks = Fs + 32 * 128;
    LAS float* Qs = Ks + 32 * 128;
    LAS float* Vs = Qs + 32 * 128;
    LAS float* Pt = Vs + 32 * 64;
    const int tid = F.tid, dvq = tid & 15, dkq = tid >> 4, wave = F.wave, lane = F.lane;
    for (int ui = blockIdx.x; ui < 256 + BS * HG_H * 2; ui += F.G) {
        int b, h, half, L, row0; float* sdst; float S[4][4];
        if (ui < 256) { b = ui >> 5; h = (ui >> 1) & 15; half = ui & 1; L = LP; row0 = b * LP; sdst = outp;
#pragma unroll
            for (int i = 0; i < 4; ++i)
#pragma unroll
                for (int e = 0; e < 4; ++e) S[i][e] = 0.f;
        } else { const int su = ui - 256; b = su >> 5; h = (su >> 1) & 15; half = su & 1; L = LS; row0 = MP + b * LS; sdst = outs;
#pragma unroll
            for (int i = 0; i < 4; ++i) { const f32x4 v = *(const GAS f32x4*)(s0s + ((size_t)(b * HG_H + h) * HG_DK + 4 * dkq + i) * HG_DV + half * 64 + 4 * dvq); S[i][0] = v.x; S[i][1] = v.y; S[i][2] = v.z; S[i][3] = v.w; }
        }
        sdst += ((size_t)(b * HG_H + h) * HG_DK + 4 * dkq) * HG_DV + half * 64 + 4 * dvq;
        for (int c0 = 0; c0 < L; c0 += 32) {
            const int tn = (L - c0) < 32 ? (L - c0) : 32;
            { const int t = tid >> 4, v = tid & 15;
              if (t < tn) { const size_t ro = (size_t)(row0 + c0 + t) * 8192; float q[8], f[8];
                  unpack8(*(const GAS v4u*)(P + ro + h * 128 + 8 * v), q); unpack8(*(const GAS v4u*)(P + ro + 2048 + h * 128 + 8 * v), f);
                  float fo[8], ko[8], qo[8];
#pragma unroll
                  for (int e = 0; e < 8; ++e) { const float lb = LBl[h * 128 + 8 * v + e]; const float sg = sigmoid_f(f[e]); fo[e] = lb + (1.0f - lb) * sg; ko[e] = (1.0f - lb) * (1.0f - sg); qo[e] = silu_f(q[e]); }
                  *(LAS f32x4*)(Fs + t * 128 + 8 * v) = (f32x4){fo[0], fo[1], fo[2], fo[3]}; *(LAS f32x4*)(Fs + t * 128 + 8 * v + 4) = (f32x4){fo[4], fo[5], fo[6], fo[7]};
                  *(LAS f32x4*)(Ks + t * 128 + 8 * v) = (f32x4){ko[0], ko[1], ko[2], ko[3]}; *(LAS f32x4*)(Ks + t * 128 + 8 * v + 4) = (f32x4){ko[4], ko[5], ko[6], ko[7]};
                  *(LAS f32x4*)(Qs + t * 128 + 8 * v) = (f32x4){qo[0], qo[1], qo[2], qo[3]}; *(LAS f32x4*)(Qs + t * 128 + 8 * v + 4) = (f32x4){qo[4], qo[5], qo[6], qo[7]}; } }
            if (tid < 256) { const int t = tid >> 3, v = tid & 7;
              if (t < tn) { float f[8]; unpack8(*(const GAS v4u*)(P + (size_t)(row0 + c0 + t) * 8192 + 4096 + h * 128 + half * 64 + 8 * v), f);
                  *(LAS f32x4*)(Vs + t * 64 + 8 * v) = (f32x4){f[0], f[1], f[2], f[3]}; *(LAS f32x4*)(Vs + t * 64 + 8 * v + 4) = (f32x4){f[4], f[5], f[6], f[7]}; } }
            __syncthreads();
            for (int t = 0; t < tn; ++t) {
                const f32x4 fv = *(const LAS f32x4*)(Fs + t * 128 + 4 * dkq), kv = *(const LAS f32x4*)(Ks + t * 128 + 4 * dkq), qv = *(const LAS f32x4*)(Qs + t * 128 + 4 * dkq), vv = *(const LAS f32x4*)(Vs + t * 64 + 4 * dvq);
                const float ff[4] = {fv.x, fv.y, fv.z, fv.w}, kk[4] = {kv.x, kv.y, kv.z, kv.w}, qq[4] = {qv.x, qv.y, qv.z, qv.w};
                float acc[4] = {0.f, 0.f, 0.f, 0.f};
#pragma unroll
                for (int i = 0; i < 4; ++i) { S[i][0] = ff[i] * S[i][0] + kk[i] * vv.x; S[i][1] = ff[i] * S[i][1] + kk[i] * vv.y; S[i][2] = ff[i] * S[i][2] + kk[i] * vv.z; S[i][3] = ff[i] * S[i][3] + kk[i] * vv.w;
                    acc[0] += qq[i] * S[i][0]; acc[1] += qq[i] * S[i][1]; acc[2] += qq[i] * S[i][2]; acc[3] += qq[i] * S[i][3]; }
#pragma unroll
                for (int e = 0; e < 4; ++e) { acc[e] += __shfl_xor(acc[e], 16); acc[e] += __shfl_xor(acc[e], 32); }
                if (lane < 16) *(LAS f32x4*)(Pt + (t * 8 + wave) * 64 + 4 * dvq) = (f32x4){acc[0], acc[1], acc[2], acc[3]};
            }
            __syncthreads();
            { const int t = tid >> 4, d4 = (tid & 15) * 4;
              if (t < tn) { f32x4 s = (f32x4){0.f, 0.f, 0.f, 0.f};
#pragma unroll
                  for (int w = 0; w < 8; ++w) s = s + *(const LAS f32x4*)(Pt + (t * 8 + w) * 64 + d4);
                  *(GAS f32x4*)(OH + (size_t)(row0 + c0 + t) * BR + h * 128 + half * 64 + d4) = s; } }
            __syncthreads();
        }
#pragma unroll
        for (int i = 0; i < 4; ++i) *(GAS f32x4*)(sdst + (size_t)i * HG_DV) = (f32x4){S[i][0], S[i][1], S[i][2], S[i][3]};
    }
}
__device__ __forceinline__ void hgrn_norm(const Frame& F, const float* OH, const bf16* P, bf16* HG) {
    for (int r = F.gw; r < MT; r += F.NGW) {
        const GAS f32x4* orow = (const GAS f32x4*)(OH + (size_t)r * BR) + F.lane; GAS v2u* o8 = (GAS v2u*)(HG + (size_t)r * BR) + F.lane;
        const GAS v2u* g8 = (const GAS v2u*)(P + (size_t)r * 8192 + 6144) + F.lane;
#pragma unroll
        for (int j = 0; j < 8; ++j) { const f32x4 v = orow[64 * j]; float s = (v.x * v.x + v.y * v.y) + (v.z * v.z + v.w * v.w);
            s += __shfl_xor(s, 1); s += __shfl_xor(s, 2); s += __shfl_xor(s, 4); s += __shfl_xor(s, 8); s += __shfl_xor(s, 16);
            const float rstd = 1.0f / sqrtf(s * (1.f / 128.f) + EPS); const v2u gw = g8[64 * j];
            v2u w; w.x = pk2(v.x * rstd * silu_f(bflo(gw.x)), v.y * rstd * silu_f(bfhi(gw.x))); w.y = pk2(v.z * rstd * silu_f(bflo(gw.y)), v.w * rstd * silu_f(bfhi(gw.y))); o8[64 * j] = w; }
    }
}

__device__ __forceinline__ void attn_prompt(const Frame& F, const bf16* Q, const bf16* KP, const bf16* VT, bf16* O) {
    const int lane = F.lane, l15 = lane & 15, lq = lane >> 4;
    for (int ui = blockIdx.x; ui < BP * 4 * 16; ui += F.G) {
        const int qt = ui & 15, h = (ui >> 4) & 3, b = ui >> 6;
        const int r0 = b * LP + qt * 128 + F.wave * 16;
        bf16x8 Qb[8];
#pragma unroll
        for (int ks = 0; ks < 8; ++ks) Qb[ks] = *(const GAS bf16x8*)(Q + (size_t)(r0 + l15) * DM + h * 256 + ks * 32 + 8 * lq);
        f32x4 ST[16];
        const bf16* kb_base = KP + (size_t)(b * NMEM + l15) * DM + h * 256 + 8 * lq;
#pragma unroll
        for (int kb = 0; kb < 16; ++kb) { f32x4 acc = (f32x4){0.f, 0.f, 0.f, 0.f};
#pragma unroll
            for (int ks = 0; ks < 8; ++ks) { const bf16x8 Ka = *(const GAS bf16x8*)(kb_base + (size_t)(kb * 16) * DM + ks * 32); acc = __builtin_amdgcn_mfma_f32_16x16x32_bf16(Ka, Qb[ks], acc, 0, 0, 0); }
            ST[kb] = acc; }
        float mx = -3.0e38f;
#pragma unroll
        for (int kb = 0; kb < 16; ++kb) mx = fmaxf(mx, fmaxf(fmaxf(ST[kb].x, ST[kb].y), fmaxf(ST[kb].z, ST[kb].w)));
        mx = fmaxf(mx, __shfl_xor(mx, 16)); mx = fmaxf(mx, __shfl_xor(mx, 32));
        float sum = 0.f;
#pragma unroll
        for (int kb = 0; kb < 16; ++kb) { ST[kb].x = __expf(ST[kb].x - mx); ST[kb].y = __expf(ST[kb].y - mx); ST[kb].z = __expf(ST[kb].z - mx); ST[kb].w = __expf(ST[kb].w - mx); sum += (ST[kb].x + ST[kb].y) + (ST[kb].z + ST[kb].w); }
        sum += __shfl_xor(sum, 16); sum += __shfl_xor(sum, 32);
        const float inv = 1.0f / sum;
        bf16x8 Pb[8];
#pragma unroll
        for (int s = 0; s < 8; ++s) { v4u w; w.x = pk2(ST[2 * s].x, ST[2 * s].y); w.y = pk2(ST[2 * s].z, ST[2 * s].w); w.z = pk2(ST[2 * s + 1].x, ST[2 * s + 1].y); w.w = pk2(ST[2 * s + 1].z, ST[2 * s + 1].w); Pb[s] = __builtin_bit_cast(bf16x8, w); }
        const bf16* vt_base = VT + (size_t)(h * 256 + l15) * 2048 + b * NMEM + 4 * lq;
#pragma unroll 4
        for (int db = 0; db < 16; ++db) { f32x4 acc = (f32x4){0.f, 0.f, 0.f, 0.f};
#pragma unroll
            for (int s = 0; s < 8; ++s) { const bf16* vp = vt_base + (size_t)(db * 16) * 2048 + 32 * s; const v2u lo = *(const GAS v2u*)vp, hi = *(const GAS v2u*)(vp + 16);
                v4u w; w.x = lo.x; w.y = lo.y; w.z = hi.x; w.w = hi.y; acc = __builtin_amdgcn_mfma_f32_16x16x32_bf16(__builtin_bit_cast(bf16x8, w), Pb[s], acc, 0, 0, 0); }
            v2u w; w.x = pk2(acc.x * inv, acc.y * inv); w.y = pk2(acc.z * inv, acc.w * inv);
            *(GAS v2u*)(O + (size_t)(r0 + l15) * DM + h * 256 + db * 16 + 4 * lq) = w; }
    }
}
__device__ __forceinline__ void attn_sample(const Frame& F, const bf16* Q, const float* CK, const float* CV, bf16* O) {
    LAS float* redm = (LAS float*)F.lds;
    LAS float* reds = redm + 64;
    LAS float* Pl = reds + 64;
    LAS float* Ored = Pl + 8 * 256;
    const int lane = F.lane, l15 = lane & 15, lq = lane >> 4, wave = F.wave, tid = F.tid;
    for (int ui = blockIdx.x; ui < BS * 4; ui += F.G) {
        const int h = ui & 3, b = ui >> 2;
        bf16x8 Qb[8];
#pragma unroll
        for (int ks = 0; ks < 8; ++ks) { v4u w = (v4u){0u, 0u, 0u, 0u}; if (l15 < 8) w = *(const GAS v4u*)(Q + (size_t)(MP + b * LS + l15) * DM + h * 256 + ks * 32 + 8 * lq); Qb[ks] = __builtin_bit_cast(bf16x8, w); }
        f32x4 ST[2];
#pragma unroll
        for (int kb = 0; kb < 2; ++kb) { f32x4 acc = (f32x4){0.f, 0.f, 0.f, 0.f};
            const float* kp = CK + ((size_t)(b * NMEM + wave * 32 + kb * 16 + l15)) * DM + h * 256 + 8 * lq;
#pragma unroll
            for (int ks = 0; ks < 8; ++ks) { const f32x4 k0 = *(const GAS f32x4*)(kp + ks * 32), k1 = *(const GAS f32x4*)(kp + ks * 32 + 4);
                v4u w; w.x = pk2(k0.x, k0.y); w.y = pk2(k0.z, k0.w); w.z = pk2(k1.x, k1.y); w.w = pk2(k1.z, k1.w);
                acc = __builtin_amdgcn_mfma_f32_16x16x32_bf16(__builtin_bit_cast(bf16x8, w), Qb[ks], acc, 0, 0, 0); }
            ST[kb] = acc; }
        float mx = fmaxf(fmaxf(fmaxf(ST[0].x, ST[0].y), fmaxf(ST[0].z, ST[0].w)), fmaxf(fmaxf(ST[1].x, ST[1].y), fmaxf(ST[1].z, ST[1].w)));
        mx = fmaxf(mx, __shfl_xor(mx, 16)); mx = fmaxf(mx, __shfl_xor(mx, 32));
        if (lane < 8) redm[wave * 8 + lane] = mx;
        __syncthreads();
        float gm = -3.0e38f;
#pragma unroll
        for (int w = 0; w < 8; ++w) gm = fmaxf(gm, redm[w * 8 + (l15 & 7)]);
        float sum = 0.f;
#pragma unroll
        for (int kb = 0; kb < 2; ++kb) { ST[kb].x = __expf(ST[kb].x - gm); ST[kb].y = __expf(ST[kb].y - gm); ST[kb].z = __expf(ST[kb].z - gm); ST[kb].w = __expf(ST[kb].w - gm); sum += (ST[kb].x + ST[kb].y) + (ST[kb].z + ST[kb].w);
            if (l15 < 8) *(LAS f32x4*)(Pl + l15 * 256 + wave * 32 + kb * 16 + 4 * lq) = ST[kb]; }
        sum += __shfl_xor(sum, 16); sum += __shfl_xor(sum, 32);
        if (lane < 8) reds[wave * 8 + lane] = sum;
        __syncthreads();
        f32x4 o[8];
#pragma unroll
        for (int q = 0; q < 8; ++q) o[q] = (f32x4){0.f, 0.f, 0.f, 0.f};
        const float* vp = CV + ((size_t)(b * NMEM + wave * 32)) * DM + h * 256 + 4 * lane;
#pragma unroll 4
        for (int k = 0; k < 32; ++k) { const f32x4 v = *(const GAS f32x4*)(vp + (size_t)k * DM);
#pragma unroll
            for (int q = 0; q < 8; ++q) { const float pq = Pl[q * 256 + wave * 32 + k]; o[q] = o[q] + v * pq; } }
#pragma unroll
        for (int q = 0; q < 8; ++q) *(LAS f32x4*)(Ored + (wave * 8 + q) * 256 + 4 * lane) = o[q];
        __syncthreads();
        { const int q = tid >> 6, d4 = (tid & 63) * 4; float tot = 0.f;
#pragma unroll
          for (int w = 0; w < 8; ++w) tot += reds[w * 8 + q];
          f32x4 s = (f32x4){0.f, 0.f, 0.f, 0.f};
#pragma unroll
          for (int w = 0; w < 8; ++w) s = s + *(const LAS f32x4*)(Ored + (w * 8 + q) * 256 + d4);
          const float inv = 1.0f / tot; v2u w2; w2.x = pk2(s.x * inv, s.y * inv); w2.y = pk2(s.z * inv, s.w * inv);
          *(GAS v2u*)(O + (size_t)(MP + b * LS + q) * DM + h * 256 + d4) = w2; }
        __syncthreads();
    }
}

typedef const __attribute__((address_space(4))) Args* ArgsP;
__device__ __forceinline__ Frame make_frame(LAS unsigned char* lds) {
    Frame F; int t = threadIdx.x; asm volatile("" : "+v"(t));
    F.lds = lds; F.tid = t; F.lane = t & 63; F.wave = __builtin_amdgcn_readfirstlane(t >> 6);
    F.G = gridDim.x; { const int bx = blockIdx.x; F.vcu = (F.G % 8 == 0) ? (bx % 8) * (F.G / 8) + bx / 8 : bx; }
    F.gw = F.vcu * NWAVES + F.wave; F.NGW = F.G * NWAVES; F.gt = F.vcu * NTHR + F.tid; F.NGT = F.G * NTHR;
    return F;
}
#define PH_BEGIN ArgsP A_ = ap0; asm volatile("" : "+s"(A_)); const Frame F = make_frame(ldsp); unsigned char* const ws = A_->ws; float* const OUT = A_->out; (void)OUT; (void)ws

__global__ void __launch_bounds__(NTHR, 2) mega_fwd(Args args) {
    extern __shared__ __attribute__((aligned(16))) unsigned char lds[];
    LAS unsigned char* const ldsp = (LAS unsigned char*)lds;
    const ArgsP ap0 = (ArgsP)__builtin_amdgcn_kernarg_segment_ptr();
    XcdBarrier bar;
    { volatile LAS unsigned* MISC = (volatile LAS unsigned*)(ldsp + MISC_OFF);
      for (int u = threadIdx.x; u < (LDS_BYTES - LDSCTL_OFF) / 4; u += NTHR) ((LAS unsigned*)(ldsp + LDSCTL_OFF))[u] = 0u;
      __syncthreads();
      bar = xcd_barrier_post((unsigned*)(args.ws + WS_CTL) + 4096, MISC + 8); }
#define GRID_BAR() xcd_barrier(bar)

    { PH_BEGIN; p0_prologue(F, A_); }
    GRID_BAR();

    { PH_BEGIN; pg8::Gemm g{(const bf16*)(ws + WS_MEMN), (const bf16*)(ws + WS_WMEM), BP * NMEM, 8192, DM, DM, -1}; pg8::StaticOrder S; S.init(g.M, g.N, F.G, (int)blockIdx.x);
      pg8::EpiMemKV E{OUT + O_MKP, OUT + O_MVP, (bf16*)(ws + WS_KP)};
      pg8::gemm_phase<pg8::EpiMemKV, pg8::StaticOrder>(F.lds, g, S, E); }
    { PH_BEGIN; pg8::Gemm g{(const bf16*)(ws + WS_WMEM) + (size_t)4096 * DM, (const bf16*)(ws + WS_MEMN), 4096, BP * NMEM, DM, DM, -1}; pg8::StaticOrder S; S.init(g.M, g.N, F.G, (int)blockIdx.x);
      pg8::EpiBf16 E{(bf16*)(ws + WS_VT), BP * NMEM};
      pg8::gemm_phase<pg8::EpiBf16, pg8::StaticOrder>(F.lds, g, S, E); }

    for (int layer = 0; layer < DEPTH; ++layer) {
        const int kind = layer % 3, idx = layer / 3;
        { PH_BEGIN;
          const bf16* win = kind == 0 ? (const bf16*)(ws + WS_RGWIN) + (size_t)idx * 4096 * DM : kind == 1 ? (const bf16*)(ws + WS_SSDWIN) : (const bf16*)(ws + WS_HGWIN);
          const int nin = kind == 0 ? 4096 : kind == 1 ? SSD_NPAD : 8192;
          pg8::Gemm g{(const bf16*)(ws + WS_XN), win, MT, nin, DM, DM, -1}; pg8::StaticOrder S; S.init(MT, nin, F.G, (int)blockIdx.x);
          pg8::EpiBf16 E{(bf16*)(ws + WS_P), nin};
          pg8::gemm_phase<pg8::EpiBf16, pg8::StaticOrder>(F.lds, g, S, E); }
        GRID_BAR();
        if (kind == 0) {
            { PH_BEGIN;
              conv_phase<false>(F, (const bf16*)(ws + WS_P), 4096, 0, BR, A_->in[I_ST_RGC] + (size_t)idx * BS * 3 * BR, A_->in[I_RG_CW] + (size_t)idx * 4 * BR, A_->in[I_RG_CB] + (size_t)idx * BR, (bf16*)(ws + WS_T1),
                                OUT + O_RGCP + (size_t)idx * BP * 3 * BR, OUT + O_RGCS + (size_t)idx * BS * 3 * BR); }
            GRID_BAR();
            { PH_BEGIN; pg8::Gemm g{(const bf16*)(ws + WS_T1), (const bf16*)(ws + WS_RGWAX) + (size_t)idx * 4096 * 256, MT, 4096, 256, BR, 1}; pg8::StaticOrder S; S.init(MT, 4096, F.G, (int)blockIdx.x);
              pg8::EpiBf16 E{(bf16*)(ws + WS_T2), 4096};
              pg8::gemm_phase<pg8::EpiBf16, pg8::StaticOrder>(F.lds, g, S, E); }
            GRID_BAR();
            { PH_BEGIN; RgPar rp{(const bf16*)(ws + WS_T1), (const bf16*)(ws + WS_T2), (const bf16*)(ws + WS_P), A_->in[I_RG_BA] + (size_t)idx * BR, A_->in[I_RG_BX] + (size_t)idx * BR, A_->in[I_RG_LAM] + (size_t)idx * BR};
              rg_scan_a(F, rp, (float*)(ws + WS_CA), (float*)(ws + WS_CB)); }
            GRID_BAR();
            { PH_BEGIN; RgPar rp{(const bf16*)(ws + WS_T1), (const bf16*)(ws + WS_T2), (const bf16*)(ws + WS_P), A_->in[I_RG_BA] + (size_t)idx * BR, A_->in[I_RG_BX] + (size_t)idx * BR, A_->in[I_RG_LAM] + (size_t)idx * BR};
              rg_scan_b(F, rp, (const float*)(ws + WS_CA), (const float*)(ws + WS_CB), A_->in[I_ST_RGH] + (size_t)idx * BS * BR, (bf16*)(ws + WS_HGB), OUT + O_RGHP + (size_t)idx * BP * BR, OUT + O_RGHS + (size_t)idx * BS * BR); }
        } else if (kind == 1) {
            { PH_BEGIN;
              conv_phase<true>(F, (const bf16*)(ws + WS_P), SSD_NPAD, 2048, SSD_CONV, A_->in[I_ST_SC], A_->in[I_SSD_CW], A_->in[I_SSD_CB], (bf16*)(ws + WS_T1), OUT + O_SCP, OUT + O_SCS);
              ssd_dt_phase(F, (const bf16*)(ws + WS_P), A_->in[I_SSD_DTB], (float*)(ws + WS_DT)); }
            GRID_BAR();
            { PH_BEGIN; ssd_scan(F, (const bf16*)(ws + WS_T1), (const bf16*)(ws + WS_P), (const float*)(ws + WS_DT), A_->in[I_SSD_ALOG], A_->in[I_SSD_D], A_->in[I_ST_SS], (float*)(ws + WS_T2), OUT + O_SSP, OUT + O_SSS); }
            GRID_BAR();
            { PH_BEGIN; ssd_norm(F, (const float*)(ws + WS_T2), (bf16*)(ws + WS_HGB)); }
        } else {
            { PH_BEGIN; hgrn_scan(F, (const bf16*)(ws + WS_P), (const float*)(ws + WS_LB) + (size_t)layer * BR, A_->in[I_ST_HG], (float*)(ws + WS_T2), OUT + O_HSP, OUT + O_HSS); }
            GRID_BAR();
            { PH_BEGIN; hgrn_norm(F, (const float*)(ws + WS_T2), (const bf16*)(ws + WS_P), (bf16*)(ws + WS_HGB)); }
        }
        GRID_BAR();
        { PH_BEGIN;
          const bf16* wout = kind == 0 ? (const bf16*)(ws + WS_RGWOUT) + (size_t)idx * DM * BR : kind == 1 ? (const bf16*)(ws + WS_SSDWOUT) : (const bf16*)(ws + WS_HGWOUT);
          pg8::Gemm g{(const bf16*)(ws + WS_HGB), wout, MT, DM, BR, BR, -1}; pg8::StaticOrder S; S.init(MT, DM, F.G, (int)blockIdx.x);
          pg8::EpiF32 E{(float*)(ws + WS_Y), DM};
          pg8::gemm_phase<pg8::EpiF32, pg8::StaticOrder>(F.lds, g, S, E); }
        GRID_BAR();
        { PH_BEGIN; thin_pass(F, (const float*)(ws + WS_Y), OUT, (bf16*)(ws + WS_XN), A_->in[I_NG] + (size_t)(layer * 4 + 1) * DM, true); }
        GRID_BAR();
        { PH_BEGIN; pg8::Gemm g{(const bf16*)(ws + WS_XN), (const bf16*)(ws + WS_XWQ) + (size_t)layer * DM * DM, MT, DM, DM, DM, -1}; pg8::StaticOrder S; S.init(MT, DM, F.G, (int)blockIdx.x);
          pg8::EpiBf16 E{(bf16*)(ws + WS_Q), DM};
          pg8::gemm_phase<pg8::EpiBf16, pg8::StaticOrder>(F.lds, g, S, E); }
        GRID_BAR();
        { PH_BEGIN; attn_prompt(F, (const bf16*)(ws + WS_Q), (const bf16*)(ws + WS_KP) + (size_t)layer * 2048 * DM, (const bf16*)(ws + WS_VT) + (size_t)layer * 1024 * 2048, (bf16*)(ws + WS_OA)); }
        { PH_BEGIN; attn_sample(F, (const bf16*)(ws + WS_Q), A_->in[I_CK] + (size_t)layer * BS * NMEM * DM, A_->in[I_CV] + (size_t)layer * BS * NMEM * DM, (bf16*)(ws + WS_OA)); }
        GRID_BAR();
        { PH_BEGIN; pg8::Gemm g{(const bf16*)(ws + WS_OA), (const bf16*)(ws + WS_XWO) + (size_t)layer * DM * DM, MT, DM, DM, DM, -1}; pg8::StaticOrder S; S.init(MT, DM, F.G, (int)blockIdx.x);
          pg8::EpiF32 E{(float*)(ws + WS_Y), DM};
          pg8::gemm_phase<pg8::EpiF32, pg8::StaticOrder>(F.lds, g, S, E); }
        GRID_BAR();
        { PH_BEGIN; thin_pass(F, (const float*)(ws + WS_Y), OUT, (bf16*)(ws + WS_XN), A_->in[I_NG] + (size_t)(layer * 4 + 3) * DM, layer + 1 < DEPTH); }
        if (layer + 1 < DEPTH) GRID_BAR();
    }
}

extern "C" void kernel_launch(void* const* d_in, const int* in_sizes, int n_in, void* d_out, int out_size, void* d_ws, size_t ws_size, hipStream_t stream) {
    static int grid = 0;
    if (grid == 0) {
        if (n_in != N_IN || (size_t)out_size != O_END || ws_size < WS_END) { fprintf(stderr, "kernel_launch: unexpected sizes: n_in %d out %d ws %zu\n", n_in, out_size, ws_size); grid = -1; return; }
        int dev = 0, cus = 0, per_cu = 0;
        if (hipGetDevice(&dev) != hipSuccess || hipDeviceGetAttribute(&cus, hipDeviceAttributeMultiprocessorCount, dev) != hipSuccess) { grid = -1; return; }
        if (hipFuncSetAttribute((const void*)mega_fwd, hipFuncAttributeMaxDynamicSharedMemorySize, LDS_BYTES) != hipSuccess) { fprintf(stderr, "kernel_launch: hipFuncSetAttribute failed\n"); grid = -1; return; }
        if (hipOccupancyMaxActiveBlocksPerMultiprocessor(&per_cu, (const void*)mega_fwd, NTHR, LDS_BYTES) != hipSuccess || per_cu < 1) fprintf(stderr, "kernel_launch: occupancy query reports %d\n", per_cu);
        (void)hipGetLastError();
        grid = cus;
    }
    if (grid < 0) return;
    (void)hipMemsetAsync((char*)d_ws + WS_CTL, 0, CTL_ZERO_BYTES, stream);
    Args a{};
    for (int i = 0; i < N_IN; ++i) a.in[i] = (const float*)d_in[i];
    a.out = (float*)d_out; a.ws = (unsigned char*)d_ws;
    unsigned char* ws = (unsigned char*)d_ws;
    int nd = 0, items = 0;
    auto add = [&](const float* src, const float* gain, size_t dst_off, int K, int N, float scale) {
        WDesc& d = a.wd[nd++]; d.src = src; d.gain = gain; d.dst = (bf16*)(ws + dst_off); d.K = K; d.N = N; d.scale = scale; d.item0 = items; items += (K / 64) * (N / 32); };
    const float* NG = a.in[I_NG];
    for (int l = 0; l < DEPTH; ++l) {
        add(a.in[I_XWK] + (size_t)l * DM * DM, a.in[I_MNG] + (size_t)l * DM, WS_WMEM + ((size_t)l * 1024) * DM * 2, DM, DM, 1.f);
        add(a.in[I_XWV] + (size_t)l * DM * DM, a.in[I_MNG] + (size_t)l * DM, WS_WMEM + ((size_t)4096 + (size_t)l * 1024) * DM * 2, DM, DM, 1.f);
    }
    for (int i = 0; i < 2; ++i) {
        const int layer = 3 * i;
        add(a.in[I_RG_WIN] + (size_t)i * DM * 4096, NG + (size_t)(layer * 4 + 0) * DM, WS_RGWIN + (size_t)i * 4096 * DM * 2, DM, 4096, 1.f);
        for (int j = 0; j < 8; ++j) {
            add(a.in[I_RG_WA] + ((size_t)i * 8 + j) * 256 * 256, nullptr, WS_RGWAX + ((size_t)i * 4096 + (size_t)j * 512) * 256 * 2, 256, 256, 1.f);
            add(a.in[I_RG_WX] + ((size_t)i * 8 + j) * 256 * 256, nullptr, WS_RGWAX + ((size_t)i * 4096 + (size_t)j * 512 + 256) * 256 * 2, 256, 256, 1.f);
        }
        add(a.in[I_RG_WOUT] + (size_t)i * BR * DM, nullptr, WS_RGWOUT + (size_t)i * DM * BR * 2, BR, DM, 1.f);
    }
    add(a.in[I_SSD_WIN], NG + (size_t)(1 * 4 + 0) * DM, WS_SSDWIN, DM, SSD_NIN, 1.f);
    add(a.in[I_SSD_WOUT], a.in[I_SSD_NG], WS_SSDWOUT, BR, DM, 1.f);
    add(a.in[I_HG_WIN], NG + (size_t)(2 * 4 + 0) * DM, WS_HGWIN, DM, 8192, 1.f);
    add(a.in[I_HG_WOUT], a.in[I_HG_NG], WS_HGWOUT, BR, DM, 1.f);
    for (int l = 0; l < DEPTH; ++l) {
        add(a.in[I_XWQ] + (size_t)l * DM * DM, NG + (size_t)(l * 4 + 2) * DM, WS_XWQ + (size_t)l * DM * DM * 2, DM, DM, 0.0625f);
        add(a.in[I_XWO] + (size_t)l * DM * DM, nullptr, WS_XWO + (size_t)l * DM * DM * 2, DM, DM, 1.f);
    }
    if (nd != NWD) { fprintf(stderr, "kernel_launch: descriptor count %d != %d\n", nd, NWD); return; }
    a.nitems = items; a.pad = 0;
    hipLaunchKernelGGL(mega_fwd, dim3(grid), dim3(NTHR), LDS_BYTES, stream, a);
    const hipError_t le = hipPeekAtLastError();
    if (le != hipSuccess) fprintf(stderr, "kernel_launch: launch failed: %s\n", hipGetErrorName(le));
}
```

```cpp
#include <hip/hip_runtime.h>
#include <cstdio>
#include <cstdint>

namespace pg8 {
#define PG8_LAS __attribute__((address_space(3)))
typedef unsigned short bf16_t;
typedef short bf16x8 __attribute__((ext_vector_type(8)));
typedef float f32x4 __attribute__((ext_vector_type(4)));
typedef unsigned u32x4 __attribute__((ext_vector_type(4)));
typedef unsigned u32x2 __attribute__((ext_vector_type(2)));
constexpr int BM = 256, BK = 64, HALF = 128, HTB = HALF * BK * 2, STAGE_BYTES = 8 * HTB, NXCD = 8, WGM = 8;

__host__ __device__ __forceinline__ int lds_byte(int r, int c) { const int st = (r >> 4) * 2 + (c >> 5), rr = r & 15, cc = c & 31, ob = rr * 64 + cc * 2; return st * 1024 + (ob ^ (((ob >> 9) & 1) << 5)); }
__host__ __device__ __forceinline__ void stage_rc(int b, int& R, int& C) { const int st = b / 1024, sb = b % 1024, swz = sb ^ (((sb >> 9) & 1) << 5); R = (st >> 1) * 16 + swz / 64; C = (st & 1) * 32 + (swz % 64) / 2; }
__host__ __device__ __forceinline__ int perm32(int rho) { const int n = rho >> 4, i = rho & 15; return 8 * (i >> 2) + 4 * n + (i & 3); }

struct Unit { int pm, pn; };
struct Gemm { const bf16_t* A; const bf16_t* Bt; int M, N, K, lda, a_shift; };

struct StaticOrder {
    int nM, nN, nwg, G, c;
    __host__ __device__ void init(int M, int N, int G_, int c_) { nM = M / BM; nN = N / BM; nwg = nM * nN; G = G_; c = c_; }
    __host__ __device__ bool next(int i, Unit& u) const {
        const long L = (long)i * G + c; if (L >= nwg) return false;
        int wgid = (int)L; { const int q = nwg / NXCD, r = nwg % NXCD, xcd = wgid % NXCD, off = wgid / NXCD; wgid = (xcd < r ? xcd * (q + 1) : r * (q + 1) + (xcd - r) * q) + off; }
        const int nig = WGM * nN, gid = wgid / nig, fm = gid * WGM, gsz = (nM - fm) < WGM ? (nM - fm) : WGM;
        u.pm = fm + ((wgid % nig) % gsz); u.pn = (wgid % nig) / gsz; return true;
    }
    __device__ __forceinline__ void a_ready(const Unit&) const {}
    __device__ __forceinline__ void done(const Unit&) const {}
};

__device__ __forceinline__ unsigned cvt_pk_bf16(float lo, float hi) { unsigned r; asm volatile("v_cvt_pk_bf16_f32 %0, %1, %2" : "=v"(r) : "v"(lo), "v"(hi)); return r; }

struct EpiF32 {
    static constexpr bool PERM = false, AFTER_DRAIN = false;
    float* C; int ldc;
    __device__ __forceinline__ void operator()(const f32x4 (&acc)[2][2][4][2], const Unit& u, int wr, int wc, int fr, int fq) const {
        const int row0 = u.pm * BM + wr * 64 + fr, col0 = u.pn * BM + wc * 32 + 4 * fq;
#pragma unroll
        for (int ai = 0; ai < 2; ++ai)
#pragma unroll
            for (int m = 0; m < 4; ++m) { float* rowp = C + (size_t)(row0 + ai * HALF + m * 16) * ldc + col0;
#pragma unroll
                for (int bj = 0; bj < 2; ++bj)
#pragma unroll
                    for (int n = 0; n < 2; ++n) *(f32x4*)(rowp + bj * HALF + n * 16) = acc[ai][bj][m][n]; }
    }
};
struct EpiBf16 {
    static constexpr bool PERM = true, AFTER_DRAIN = false;
    bf16_t* O; int ldc;
    __device__ __forceinline__ void operator()(const f32x4 (&acc)[2][2][4][2], const Unit& u, int wr, int wc, int fr, int fq) const {
        const int row0 = u.pm * BM + wr * 64 + fr, col0 = u.pn * BM + wc * 32 + 8 * fq;
#pragma unroll
        for (int ai = 0; ai < 2; ++ai)
#pragma unroll
            for (int m = 0; m < 4; ++m) { bf16_t* rowp = O + (size_t)(row0 + ai * HALF + m * 16) * ldc + col0;
#pragma unroll
                for (int bj = 0; bj < 2; ++bj) { const f32x4 v0 = acc[ai][bj][m][0], v1 = acc[ai][bj][m][1];
                    u32x4 w; w.x = cvt_pk_bf16(v0[0], v0[1]); w.y = cvt_pk_bf16(v0[2], v0[3]); w.z = cvt_pk_bf16(v1[0], v1[1]); w.w = cvt_pk_bf16(v1[2], v1[3]);
                    *(u32x4*)(rowp + bj * HALF) = w; } }
    }
};
struct EpiMemKV {
    static constexpr bool PERM = false, AFTER_DRAIN = false;
    float* outK; float* outV; bf16_t* KP;
    __device__ __forceinline__ void operator()(const f32x4 (&acc)[2][2][4][2], const Unit& u, int wr, int wc, int fr, int fq) const {
        const int kv = u.pn >> 4, layer = (u.pn >> 2) & 3, ct = u.pn & 3;
        const int row0 = u.pm * BM + wr * 64 + fr, col0 = ct * BM + wc * 32 + 4 * fq;
        float* C = (kv ? outV : outK) + (size_t)layer * 2048 * 1024;
        bf16_t* Kb = KP + (size_t)layer * 2048 * 1024;
#pragma unroll
        for (int ai = 0; ai < 2; ++ai)
#pragma unroll
            for (int m = 0; m < 4; ++m) { const size_t off = (size_t)(row0 + ai * HALF + m * 16) * 1024 + col0;
#pragma unroll
                for (int bj = 0; bj < 2; ++bj)
#pragma unroll
                    for (int n = 0; n < 2; ++n) { const f32x4 v = acc[ai][bj][m][n]; *(f32x4*)(C + off + bj * HALF + n * 16) = v;
                        if (kv == 0) { u32x2 w; w.x = cvt_pk_bf16(v[0], v[1]); w.y = cvt_pk_bf16(v[2], v[3]); *(u32x2*)(Kb + off + bj * HALF + n * 16) = w; } } }
    }
};

template <class Epi, class Sched>
__device__ __forceinline__ void gemm_phase(PG8_LAS unsigned char* lds, const Gemm g, const Sched& S, const Epi& E) {
    int tid_ = threadIdx.x; asm volatile("" : "+v"(tid_));
    const int tid = tid_, wid = __builtin_amdgcn_readfirstlane(tid >> 6), lane = tid & 63, wr = wid >> 2, wc = wid & 3, fr = lane & 15, fq = lane >> 4;
    const int K = g.K, nt = K / BK, lda = g.lda;
    unsigned voffA[2], voffB[2];
#pragma unroll
    for (int i = 0; i < 2; ++i) { int R, C; stage_rc(tid * 16 + i * 8192, R, C); const int Rb = Epi::PERM ? ((R & ~31) + perm32(R & 31)) : R;
        voffA[i] = (unsigned)(R * lda + C) * 2u; voffB[i] = (unsigned)(Rb * K + C) * 2u; }
    const size_t kstep = (size_t)(BK * 2);
    const size_t hsA = (size_t)HALF * lda * 2, tsA = 2 * hsA;
    const size_t hsB = (size_t)HALF * K * 2, tsB = 2 * hsB;
    const unsigned ldsw = (unsigned)wid * 1024u;
    const int aoff = lds_byte(wr * 64 + fr, fq * 8), boff = lds_byte(wc * 32 + fr, fq * 8);
#define PG8_SA(b, h) (((b) * 2 + (h)) * HTB)
#define PG8_SB(b, h) ((4 + (b) * 2 + (h)) * HTB)
#define PG8_STAGE(bufoff, gbase, voff) do { _Pragma("unroll") for (int _i = 0; _i < 2; ++_i) \
        __builtin_amdgcn_global_load_lds((const unsigned*)((const char*)(gbase) + (voff)[_i]), (PG8_LAS unsigned*)(lds + (bufoff) + ldsw + _i * 8192), 16, 0, 0); } while (0)
#define PG8_LDA(dst, b, h) do { _Pragma("unroll") for (int m = 0; m < 4; ++m) _Pragma("unroll") for (int k = 0; k < 2; ++k) dst[m][k] = *(const PG8_LAS bf16x8*)(lds + PG8_SA(b, h) + aoff + m * 2048 + k * 1024); } while (0)
#define PG8_LDB(dst, b, h) do { _Pragma("unroll") for (int n = 0; n < 2; ++n) _Pragma("unroll") for (int k = 0; k < 2; ++k) dst[n][k] = *(const PG8_LAS bf16x8*)(lds + PG8_SB(b, h) + boff + n * 2048 + k * 1024); } while (0)
#define PG8_MMA(ai, bj, At, Bt) do { __builtin_amdgcn_s_setprio(1); _Pragma("unroll") for (int m = 0; m < 4; ++m) _Pragma("unroll") for (int n = 0; n < 2; ++n) _Pragma("unroll") for (int k = 0; k < 2; ++k) \
        acc[ai][bj][m][n] = __builtin_amdgcn_mfma_f32_16x16x32_bf16(Bt[n][k], At[m][k], acc[ai][bj][m][n], 0, 0, 0); __builtin_amdgcn_s_setprio(0); } while (0)
#define PG8_WAIT_V(n) asm volatile("s_waitcnt vmcnt(" #n ")" ::: "memory")
#define PG8_WAIT_L(n) asm volatile("s_waitcnt lgkmcnt(" #n ")" ::: "memory")
#define PG8_BAR __builtin_amdgcn_s_barrier()
#define PG8_SCHED __builtin_amdgcn_sched_barrier(0)
#define PG8_ABASE(u) ((const char*)g.A + (size_t)(u).pm * tsA + (g.a_shift >= 0 ? (size_t)((u).pn >> g.a_shift) * 512 : (size_t)0))
    Unit cur, nxt; int ui = 0;
    if (!S.next(0, cur)) return;
    f32x4 acc[2][2][4][2];
#pragma unroll
    for (int a = 0; a < 2; ++a)
#pragma unroll
        for (int b = 0; b < 2; ++b)
#pragma unroll
            for (int m = 0; m < 4; ++m)
#pragma unroll
                for (int n = 0; n < 2; ++n) acc[a][b][m][n] = (f32x4){0.f, 0.f, 0.f, 0.f};
    bf16x8 At[4][2], B0[2][2], B1[2][2];
    const char* cA = PG8_ABASE(cur); const char* cB = (const char*)g.Bt + (size_t)cur.pn * tsB;
    S.a_ready(cur);
    PG8_STAGE(PG8_SB(0, 0), cB, voffB); PG8_STAGE(PG8_SA(0, 0), cA, voffA); PG8_STAGE(PG8_SB(0, 1), cB + hsB, voffB); PG8_STAGE(PG8_SA(0, 1), cA + hsA, voffA);
    if (wr == 1) PG8_BAR;
    PG8_WAIT_V(4); PG8_BAR;
    PG8_STAGE(PG8_SB(1, 0), cB + kstep, voffB); PG8_STAGE(PG8_SA(1, 0), cA + kstep, voffA); PG8_STAGE(PG8_SB(1, 1), cB + hsB + kstep, voffB);
    PG8_WAIT_V(6); PG8_BAR;
    for (;;) {
        const bool has_next = S.next(ui + 1, nxt);
        const char* nA = has_next ? PG8_ABASE(nxt) : cA; const char* nB = has_next ? (const char*)g.Bt + (size_t)nxt.pn * tsB : cB;
        for (int t = 0; t < nt; t += 2) {
            const bool last = (t == nt - 2);
            const char* a1 = cA + (size_t)(t + 1) * kstep;
            const char* a2 = last ? nA : cA + (size_t)(t + 2) * kstep; const char* b2 = last ? nB : cB + (size_t)(t + 2) * kstep;
            const char* a3 = a2 + kstep; const char* b3 = b2 + kstep;
            if (last && has_next) S.a_ready(nxt);
            PG8_LDB(B0, 0, 0); PG8_SCHED; PG8_LDA(At, 0, 0); PG8_STAGE(PG8_SA(1, 1), a1 + hsA, voffA);
            PG8_WAIT_L(8); PG8_BAR; PG8_WAIT_L(0); PG8_MMA(0, 0, At, B0); PG8_BAR; PG8_SCHED;
            PG8_LDB(B1, 0, 1); PG8_STAGE(PG8_SB(0, 0), b2, voffB);
            PG8_BAR; PG8_WAIT_L(0); PG8_MMA(0, 1, At, B1); PG8_BAR;
            PG8_LDA(At, 0, 1); PG8_STAGE(PG8_SA(0, 0), a2, voffA);
            PG8_BAR; PG8_WAIT_L(0); PG8_MMA(1, 0, At, B0); PG8_BAR; PG8_SCHED;
            PG8_STAGE(PG8_SB(0, 1), b2 + hsB, voffB);
            PG8_WAIT_V(6); PG8_BAR; PG8_MMA(1, 1, At, B1); PG8_BAR;
            PG8_LDB(B0, 1, 0); PG8_SCHED; PG8_LDA(At, 1, 0); PG8_STAGE(PG8_SA(0, 1), a2 + hsA, voffA);
            PG8_WAIT_L(8); PG8_BAR; PG8_WAIT_L(0); PG8_MMA(0, 0, At, B0); PG8_BAR; PG8_SCHED;
            PG8_LDB(B1, 1, 1); PG8_STAGE(PG8_SB(1, 0), b3, voffB);
            PG8_BAR; PG8_WAIT_L(0); PG8_MMA(0, 1, At, B1); PG8_BAR;
            PG8_LDA(At, 1, 1); PG8_STAGE(PG8_SA(1, 0), a3, voffA);
            PG8_BAR; PG8_WAIT_L(0); PG8_MMA(1, 0, At, B0); PG8_BAR; PG8_SCHED;
            PG8_STAGE(PG8_SB(1, 1), b3 + hsB, voffB);
            PG8_WAIT_V(6); PG8_BAR; PG8_MMA(1, 1, At, B1); PG8_BAR;
        }
        if constexpr (!Epi::AFTER_DRAIN) { E(acc, cur, wr, wc, fr, fq); S.done(cur); }
        if (!has_next) break;
#pragma unroll
        for (int a = 0; a < 2; ++a)
#pragma unroll
            for (int b = 0; b < 2; ++b)
#pragma unroll
                for (int m = 0; m < 4; ++m)
#pragma unroll
                    for (int n = 0; n < 2; ++n) acc[a][b][m][n] = (f32x4){0.f, 0.f, 0.f, 0.f};
        cur = nxt; cA = nA; cB = nB; ++ui;
    }
    PG8_WAIT_V(0);
    if (wr == 0) PG8_BAR;
    PG8_BAR;
#undef PG8_ABASE
#undef PG8_SA
#undef PG8_SB
#undef PG8_STAGE
#undef PG8_LDA
#undef PG8_LDB
#undef PG8_MMA
#undef PG8_WAIT_V
#undef PG8_WAIT_L
#undef PG8_BAR
#undef PG8_SCHED
}
}

constexpr int NWAVES = 8, NTHR = 512;
constexpr int DM = 1024, BP = 8, LP = 2048, BS = 128, LS = 8, NMEM = 256, DEPTH = 4;
constexpr int MP = BP * LP, MS = BS * LS, MT = MP + MS;
constexpr int BR = 2048;
constexpr int SSD_CONV = 4096, SSD_NIN = 6176, SSD_NPAD = 6400, SSD_H = 32, SSD_P = 64, SSD_N = 128;
constexpr int HG_H = 16, HG_DK = 128, HG_DV = 128;
constexpr float EPS = 1e-6f;

constexpr size_t O_YP = 0;
constexpr size_t O_YS = O_YP + (size_t)MP * DM;
constexpr size_t O_RGCP = O_YS + (size_t)MS * DM;
constexpr size_t O_RGHP = O_RGCP + (size_t)2 * BP * 3 * BR;
constexpr size_t O_SCP = O_RGHP + (size_t)2 * BP * BR;
constexpr size_t O_SSP = O_SCP + (size_t)BP * 3 * SSD_CONV;
constexpr size_t O_HSP = O_SSP + (size_t)BP * SSD_H * SSD_P * SSD_N;
constexpr size_t O_MKP = O_HSP + (size_t)BP * HG_H * HG_DK * HG_DV;
constexpr size_t O_MVP = O_MKP + (size_t)DEPTH * BP * NMEM * DM;
constexpr size_t O_RGCS = O_MVP + (size_t)DEPTH * BP * NMEM * DM;
constexpr size_t O_RGHS = O_RGCS + (size_t)2 * BS * 3 * BR;
constexpr size_t O_SCS = O_RGHS + (size_t)2 * BS * BR;
constexpr size_t O_SSS = O_SCS + (size_t)BS * 3 * SSD_CONV;
constexpr size_t O_HSS = O_SSS + (size_t)BS * SSD_H * SSD_P * SSD_N;
constexpr size_t O_END = O_HSS + (size_t)BS * HG_H * HG_DK * HG_DV;
static_assert(O_END == 109805568ull, "output size");

enum { I_XP = 0, I_XS, I_MEM, I_ST_RGC, I_ST_RGH, I_ST_SC, I_ST_SS, I_ST_HG, I_CK, I_CV, I_NG, I_MNG, I_RG_WIN, I_RG_CW, I_RG_CB, I_RG_WA, I_RG_BA, I_RG_WX, I_RG_BX,
       I_RG_LAM, I_RG_WOUT, I_SSD_WIN, I_SSD_CW, I_SSD_CB, I_SSD_DTB, I_SSD_ALOG, I_SSD_D, I_SSD_NG, I_SSD_WOUT, I_HG_WIN, I_HG_LB, I_HG_NG, I_HG_WOUT, I_XWQ, I_XWK, I_XWV, I_XWO, N_IN };

constexpr size_t MiB = 1u << 20;
constexpr size_t WS_CTL = 0, CTL_ZERO_BYTES = 1 * MiB;
constexpr size_t WS_LB = 1 * MiB;
constexpr size_t WS_CA = 2 * MiB, WS_CB = 4 * MiB;
constexpr size_t WS_WMEM = 8 * MiB;
constexpr size_t WS_RGWIN = WS_WMEM + 16 * MiB;
constexpr size_t WS_RGWAX = WS_RGWIN + 16 * MiB;
constexpr size_t WS_RGWOUT = WS_RGWAX + 4 * MiB;
constexpr size_t WS_SSDWIN = WS_RGWOUT + 8 * MiB;
constexpr size_t WS_SSDWOUT = WS_SSDWIN + 13 * MiB;
constexpr size_t WS_HGWIN = WS_SSDWOUT + 4 * MiB;
constexpr size_t WS_HGWOUT = WS_HGWIN + 16 * MiB;
constexpr size_t WS_XWQ = WS_HGWOUT + 4 * MiB;
constexpr size_t WS_XWO = WS_XWQ + 8 * MiB;
constexpr size_t WS_XN = 128 * MiB;
constexpr size_t WS_P = WS_XN + 36 * MiB;
constexpr size_t WS_HGB = WS_P + 288 * MiB;
constexpr size_t WS_Y = WS_HGB + 72 * MiB;
constexpr size_t WS_Q = WS_Y + 72 * MiB;
constexpr size_t WS_OA = WS_Q + 36 * MiB;
constexpr size_t WS_MEMN = WS_OA + 36 * MiB;
constexpr size_t WS_KP = WS_MEMN + 4 * MiB;
constexpr size_t WS_VT = WS_KP + 16 * MiB;
constexpr size_t WS_T1 = WS_VT + 16 * MiB;
constexpr size_t WS_T2 = WS_T1 + 144 * MiB;
constexpr size_t WS_DT = WS_T2 + 144 * MiB;
constexpr size_t WS_T3 = WS_DT + 4 * MiB;
constexpr size_t WS_END = WS_T3 + 144 * MiB;
static_assert(WS_XWO + 8 * MiB <= WS_XN, "weights region");

constexpr int RING_BYTES = 131072;
constexpr int LDS_BYTES = 147456;
constexpr int LDSCTL_OFF = LDS_BYTES - 1024, MISC_OFF = LDSCTL_OFF + 320;

#define GAS __attribute__((address_space(1)))
#define LAS __attribute__((address_space(3)))
typedef unsigned short bf16;
typedef unsigned v4u __attribute__((ext_vector_type(4)));
typedef unsigned v2u __attribute__((ext_vector_type(2)));
typedef float f32x4 __attribute__((ext_vector_type(4)));
typedef short bf16x8 __attribute__((ext_vector_type(8)));
typedef GAS unsigned gu32;
#define RLX_AGENT __ATOMIC_RELAXED, __HIP_MEMORY_SCOPE_AGENT
#define LDS_WAIT() asm volatile("s_waitcnt lgkmcnt(0)" ::: "memory")
#define VM_WAIT() asm volatile("s_waitcnt vmcnt(0)" ::: "memory")

__device__ __forceinline__ unsigned f2bf(float f) { unsigned u = __builtin_bit_cast(unsigned, f); return (u + 0x7fffu + ((u >> 16) & 1u)) >> 16; }
__device__ __forceinline__ unsigned pk2(float lo, float hi) { return f2bf(lo) | (f2bf(hi) << 16); }
__device__ __forceinline__ float bflo(unsigned w) { return __builtin_bit_cast(float, w << 16); }
__device__ __forceinline__ float bfhi(unsigned w) { return __builtin_bit_cast(float, w & 0xffff0000u); }
__device__ __forceinline__ float bf2f(bf16 v) { return __builtin_bit_cast(float, (unsigned)v << 16); }
__device__ __forceinline__ void unpack8(const v4u w, float (&f)[8]) { f[0] = bflo(w.x); f[1] = bfhi(w.x); f[2] = bflo(w.y); f[3] = bfhi(w.y); f[4] = bflo(w.z); f[5] = bfhi(w.z); f[6] = bflo(w.w); f[7] = bfhi(w.w); }
__device__ __forceinline__ v4u pack8(const float (&f)[8]) { v4u w; w.x = pk2(f[0], f[1]); w.y = pk2(f[2], f[3]); w.z = pk2(f[4], f[5]); w.w = pk2(f[6], f[7]); return w; }
__device__ __forceinline__ float sigmoid_f(float x) { return 1.0f / (1.0f + __expf(-x)); }
__device__ __forceinline__ float silu_f(float x) { return x / (1.0f + __expf(-x)); }
__device__ __forceinline__ float softplus_f(float x) { return x > 20.f ? x : log1pf(expf(x)); }

#define XB_TMO      128
#define XB_XCNT(j)  (256  + 64 * (j))
#define XB_XSUB(j)  (1280 + 64 * (j))
#define XB_XGEN(j)  (2304 + 64 * (j))
#define XB_TOP      3328
#define XB_TOPGEN   3392
#define XCD_BAR_WORDS 3456
#define XB_SPIN_CAP (1u << 18)

__device__ __forceinline__ unsigned xb_ld(unsigned* p)              { return __hip_atomic_load(p, __ATOMIC_RELAXED, __HIP_MEMORY_SCOPE_AGENT); }
__device__ __forceinline__ unsigned xb_add(unsigned* p, unsigned v) { return __hip_atomic_fetch_add(p, v, __ATOMIC_RELAXED, __HIP_MEMORY_SCOPE_AGENT); }
__device__ __forceinline__ unsigned xb_xcc_id() { return (unsigned)__builtin_amdgcn_s_getreg((3 << 11) | 20) & 0xFu; }
#define XB_SPIN(cond, bar) do { unsigned _sp = 0; while (cond) { __builtin_amdgcn_s_sleep(1); \
    if ((++_sp & 255u) == 0u) { if (xb_ld(&(bar)[XB_TMO])) break; if (_sp > XB_SPIN_CAP) { atomicAdd(&(bar)[XB_TMO], 1u); break; } } } } while (0)

struct XcdBarrier { unsigned* bar; unsigned x; volatile LAS unsigned* st; };

__device__ __forceinline__ XcdBarrier xcd_barrier_post(unsigned* bar, volatile LAS unsigned* st) {
    XcdBarrier b; b.bar = bar; b.x = xb_xcc_id(); b.st = st;
    if (threadIdx.x == 0) (void)xb_add(&bar[XB_XCNT(b.x)], 1u);
    return b;
}
__device__ __forceinline__ void xcd_barrier_complete(unsigned* bar, unsigned x, unsigned& nloc, unsigned& nx) {
    const unsigned G = gridDim.x * gridDim.y * gridDim.z;
    unsigned sum, cnt, mine, sp = 0u;
    for (;;) {
        sum = 0u; cnt = 0u; mine = 0u;
#pragma unroll
        for (unsigned j = 0; j < 16; ++j) { const unsigned c = xb_ld(&bar[XB_XCNT(j)]); sum += c; cnt += (c > 0u) ? 1u : 0u; mine = (j == x) ? c : mine; }
        if (sum == G) break;
        __builtin_amdgcn_s_sleep(1);
        if ((++sp & 255u) == 0u) { if (xb_ld(&bar[XB_TMO])) break; if (sp > XB_SPIN_CAP) { atomicAdd(&bar[XB_TMO], 1u); break; } }
    }
    nloc = mine > 0u ? mine : 1u; nx = cnt > 0u ? cnt : 1u;
}
__device__ __forceinline__ void xcd_barrier(const XcdBarrier& b) {
    asm volatile("s_waitcnt vmcnt(0)" ::: "memory");
    __syncthreads();
    if (threadIdx.x == 0) {
        unsigned* bar = b.bar;
        __builtin_amdgcn_s_waitcnt(0);
        unsigned nloc = b.st[0], nx = b.st[1];
        if (nloc == 0u) { xcd_barrier_complete(bar, b.x, nloc, nx); b.st[0] = nloc; b.st[1] = nx; }
        const unsigned old = xb_add(&bar[XB_XSUB(b.x)], 1u);
        const unsigned gen = old / nloc;
        if (old + 1u == (gen + 1u) * nloc) {
            __builtin_amdgcn_fence(__ATOMIC_RELEASE, "agent");
            asm volatile("s_waitcnt vmcnt(0)" ::: "memory");
            const unsigned og = xb_add(&bar[XB_TOP], 1u);
            const unsigned tg = og / nx;
            if (og + 1u == (tg + 1u) * nx) xb_add(&bar[XB_TOPGEN], 1u);
            else XB_SPIN(xb_ld(&bar[XB_TOPGEN]) == tg, bar);
            __builtin_amdgcn_fence(__ATOMIC_ACQUIRE, "agent");
            xb_add(&bar[XB_XGEN(b.x)], 1u);
            asm volatile("s_waitcnt vmcnt(0)" ::: "memory");
        } else {
            XB_SPIN(xb_ld(&bar[XB_XGEN(b.x)]) == gen, bar);
            __builtin_amdgcn_fence(__ATOMIC_ACQUIRE, "agent");
            asm volatile("s_waitcnt vmcnt(0)" ::: "memory");
        }
    }
    __syncthreads();
}

struct WDesc { const float* src; const float* gain; bf16* dst; int K, N; float scale; int item0; };
constexpr int NWD = 56;
struct Args { const float* in[N_IN]; float* out; unsigned char* ws; WDesc wd[NWD]; int nitems; int pad; };

struct Frame {
    LAS unsigned char* lds;
    int tid, lane, wave;
    int vcu, G;
    int gw, NGW;
    int gt, NGT;
};

__device__ __forceinline__ float wave_sum(float v) {
#pragma unroll
    for (int o = 1; o < 64; o <<= 1) v += __shfl_xor(v, o);
    return v;
}

__device__ __forceinline__ void p0_transpose_item(const WDesc& d, LAS float* scr, int item, int lane) {
    const int K = d.K, N = d.N;
    const int nblk = N / 32, kb = item / nblk, nb = item % nblk, k0 = 64 * kb, n0 = 32 * nb;
    const float* W = d.src;
#pragma unroll 8
    for (int i = 0; i < 32; ++i) { const int kk = 2 * i + (lane >> 5); const float gsc = (d.gain ? d.gain[k0 + kk] : 1.0f) * d.scale;
        scr[kk * 33 + (lane & 31)] = W[(size_t)(k0 + kk) * N + n0 + (lane & 31)] * gsc; }
    LDS_WAIT(); asm volatile("" ::: "memory");
    const int c = lane & 7;
#pragma unroll
    for (int j = 0; j < 4; ++j) { const int n = (lane >> 3) + 8 * j; const LAS float* s = scr + (8 * c) * 33 + n;
        v4u o; o.x = pk2(s[0 * 33], s[1 * 33]); o.y = pk2(s[2 * 33], s[3 * 33]); o.z = pk2(s[4 * 33], s[5 * 33]); o.w = pk2(s[6 * 33], s[7 * 33]);
        *(GAS v4u*)(d.dst + (size_t)(n0 + n) * K + k0 + 8 * c) = o; }
    LDS_WAIT(); asm volatile("" ::: "memory");
}
__device__ __forceinline__ void rms_row_to_bf16(int lane, const float* xrow, bf16* orow, float* copy) {
    const GAS f32x4* xr = (const GAS f32x4*)xrow + lane;
    f32x4 v[4]; float s = 0.f;
#pragma unroll
    for (int j = 0; j < 4; ++j) { v[j] = xr[64 * j]; s += (v[j].x * v[j].x + v[j].y * v[j].y) + (v[j].z * v[j].z + v[j].w * v[j].w); }
    const float rstd = 1.0f / sqrtf(wave_sum(s) * (1.f / DM) + EPS);
    if (copy) { GAS f32x4* c4 = (GAS f32x4*)copy + lane;
#pragma unroll
        for (int j = 0; j < 4; ++j) c4[64 * j] = v[j]; }
    GAS v2u* o8 = (GAS v2u*)orow + lane;
#pragma unroll
    for (int j = 0; j < 4; ++j) { v2u w; w.x = pk2(v[j].x * rstd, v[j].y * rstd); w.y = pk2(v[j].z * rstd, v[j].w * rstd); o8[64 * j] = w; }
}

__device__ __forceinline__ void p0_prologue(const Frame& F, const __attribute__((address_space(4))) Args* ap) {
    const __attribute__((address_space(4))) Args& a = *ap;
    LAS float* scr = (LAS float*)(F.lds + F.wave * 16384);
    for (int it = F.gw; it < a.nitems; it += F.NGW) {
        int di = 0;
#pragma unroll 1
        for (int j = 1; j < NWD; ++j) if (it >= a.wd[j].item0) di = j;
        WDesc d; d.src = a.wd[di].src; d.gain = a.wd[di].gain; d.dst = a.wd[di].dst; d.K = a.wd[di].K; d.N = a.wd[di].N; d.scale = a.wd[di].scale; d.item0 = a.wd[di].item0;
        p0_transpose_item(d, scr, it - d.item0, F.lane);
    }
    { GAS v4u* z = (GAS v4u*)(a.ws + WS_SSDWIN + (size_t)SSD_NIN * DM * 2); const int nz = (SSD_NPAD - SSD_NIN) * DM * 2 / 16;
      for (int i = F.gt; i < nz; i += F.NGT) z[i] = (v4u){0u, 0u, 0u, 0u}; }
    { const float* lbp = a.in[I_HG_LB]; float* LB = (float*)(a.ws + WS_LB);
      for (int c = F.gt; c < BR; c += F.NGT) { const float v0 = lbp[c], v1 = lbp[BR + c], v2 = lbp[2 * BR + c], v3 = lbp[3 * BR + c];
          const float mx = fmaxf(fmaxf(v0, v1), fmaxf(v2, v3)); const float e0 = expf(v0 - mx), e1 = expf(v1 - mx), e2 = expf(v2 - mx), e3 = expf(v3 - mx); const float inv = 1.0f / (e0 + e1 + e2 + e3);
          LB[c] = 0.f; LB[BR + c] = e1 * inv; LB[2 * BR + c] = (e1 + e2) * inv; LB[3 * BR + c] = (e1 + e2 + e3) * inv; } }
    bf16* XN = (bf16*)(a.ws + WS_XN);
    for (int r = F.gw; r < MT; r += F.NGW) { const float* src = r < MP ? a.in[I_XP] + (size_t)r * DM : a.in[I_XS] + (size_t)(r - MP) * DM;
        rms_row_to_bf16(F.lane, src, XN + (size_t)r * DM, a.out + (size_t)r * DM); }
    bf16* MEMN = (bf16*)(a.ws + WS_MEMN);
    for (int r = F.gw; r < BP * NMEM; r += F.NGW) rms_row_to_bf16(F.lane, a.in[I_MEM] + (size_t)r * DM, MEMN + (size_t)r * DM, nullptr);
}

__device__ __forceinline__ void thin_pass(const Frame& F, const float* Y, float* X, bf16* XN, const float* g, bool write_xn) {
    f32x4 gv[4];
#pragma unroll
    for (int j = 0; j < 4; ++j) gv[j] = ((const GAS f32x4*)g)[64 * j + F.lane];
    for (int r = F.gw; r < MT; r += F.NGW) {
        const GAS f32x4* yr = (const GAS f32x4*)(Y + (size_t)r * DM) + F.lane;
        GAS f32x4* xr = (GAS f32x4*)(X + (size_t)r * DM) + F.lane;
        f32x4 y[4], x[4]; float s = 0.f;
#pragma unroll
        for (int j = 0; j < 4; ++j) { y[j] = yr[64 * j]; x[j] = xr[64 * j]; s += (y[j].x * y[j].x + y[j].y * y[j].y) + (y[j].z * y[j].z + y[j].w * y[j].w); }
        const float rstd = 1.0f / sqrtf(wave_sum(s) * (1.f / DM) + EPS);
        float s2 = 0.f;
#pragma unroll
        for (int j = 0; j < 4; ++j) { x[j] = x[j] + y[j] * rstd * gv[j]; s2 += (x[j].x * x[j].x + x[j].y * x[j].y) + (x[j].z * x[j].z + x[j].w * x[j].w); xr[64 * j] = x[j]; }
        if (write_xn) {
            const float rstd2 = 1.0f / sqrtf(wave_sum(s2) * (1.f / DM) + EPS);
            GAS v2u* o8 = (GAS v2u*)(XN + (size_t)r * DM) + F.lane;
#pragma unroll
            for (int j = 0; j < 4; ++j) { v2u w; w.x = pk2(x[j].x * rstd2, x[j].y * rstd2); w.y = pk2(x[j].z * rstd2, x[j].w * rstd2); o8[64 * j] = w; }
        }
    }
}

struct RowInfo { int sample, b, t, L; };
__device__ __forceinline__ RowInfo row_info(int r) { RowInfo i; if (r < MP) { i.sample = 0; i.b = r >> 11; i.t = r & 2047; i.L = LP; } else { const int rr = r - MP; i.sample = 1; i.b = rr >> 3; i.t = rr & 7; i.L = LS; } return i; }

template <bool SILU>
__device__ __forceinline__ void conv_phase(const Frame& F, const bf16* P, int ldp, int col0, int C, const float* state, const float* w, const float* bias, bf16* OUT, float* outp, float* outs) {
    const int cv = C / 8; const int total = MT * cv;
    for (int it = F.gt; it < total; it += F.NGT) {
        const int r = it / cv, c = (it - r * cv) * 8; const RowInfo ri = row_info(r);
        float u[4][8];
        unpack8(*(const GAS v4u*)(P + (size_t)r * ldp + col0 + c), u[0]);
#pragma unroll
        for (int k = 1; k < 4; ++k) {
            if (ri.t - k >= 0) unpack8(*(const GAS v4u*)(P + (size_t)(r - k) * ldp + col0 + c), u[k]);
            else if (ri.sample) { const float* sp = state + ((size_t)ri.b * 3 + (3 + ri.t - k)) * C + c; const f32x4 s0 = *(const GAS f32x4*)sp, s1 = *(const GAS f32x4*)(sp + 4);
                u[k][0] = s0.x; u[k][1] = s0.y; u[k][2] = s0.z; u[k][3] = s0.w; u[k][4] = s1.x; u[k][5] = s1.y; u[k][6] = s1.z; u[k][7] = s1.w; }
            else {
#pragma unroll
                for (int e = 0; e < 8; ++e) u[k][e] = 0.f; }
        }
        float o[8];
#pragma unroll
        for (int e = 0; e < 8; ++e) { float v = bias[c + e] + w[0 * C + c + e] * u[3][e] + w[1 * C + c + e] * u[2][e] + w[2 * C + c + e] * u[1][e] + w[3 * C + c + e] * u[0][e]; o[e] = SILU ? silu_f(v) : v; }
        *(GAS v4u*)(OUT + (size_t)r * C + c) = pack8(o);
        if (ri.t >= ri.L - 3) { float* dst = (ri.sample ? outs : outp) + ((size_t)ri.b * 3 + (ri.t - (ri.L - 3))) * C + c;
            *(GAS f32x4*)dst = (f32x4){u[0][0], u[0][1], u[0][2], u[0][3]}; *(GAS f32x4*)(dst + 4) = (f32x4){u[0][4], u[0][5], u[0][6], u[0][7]}; }
    }
}

struct RgPar { const bf16* UC; const bf16* RI; const bf16* P; const float* ba; const float* bx; const float* lam; };
__device__ __forceinline__ void rg_ab(const RgPar& p, int r, int c, const float (&sp)[4], const float (&ba)[4], const float (&bx)[4], float (&a)[4], float (&bb)[4]) {
    const int blk = c >> 8, cc = c & 255;
    const v2u uw = *(const GAS v2u*)(p.UC + (size_t)r * BR + c);
    const v2u aw = *(const GAS v2u*)(p.RI + (size_t)r * 4096 + blk * 512 + cc);
    const v2u xw = *(const GAS v2u*)(p.RI + (size_t)r * 4096 + blk * 512 + 256 + cc);
    const float u[4] = {bflo(uw.x), bfhi(uw.x), bflo(uw.y), bfhi(uw.y)};
    const float la[4] = {bflo(aw.x), bfhi(aw.x), bflo(aw.y), bfhi(aw.y)};
    const float lx[4] = {bflo(xw.x), bfhi(xw.x), bflo(xw.y), bfhi(xw.y)};
#pragma unroll
    for (int e = 0; e < 4; ++e) { const float rr = sigmoid_f(la[e] + ba[e]), ii = sigmoid_f(lx[e] + bx[e]); const float log_a = -8.0f * rr * sp[e];
        a[e] = expf(log_a); bb[e] = sqrtf(-expm1f(2.0f * log_a)) * (ii * u[e]); }
}
__device__ __forceinline__ void rg_scan_a(const Frame& F, const RgPar& p, float* CA, float* CB) {
    for (int it = F.gt; it < BP * 32 * 512; it += F.NGT) {
        const int c = (it & 511) * 4, ch = (it >> 9) & 31, b = it >> 14;
        float sp[4], ba[4], bx[4];
#pragma unroll
        for (int e = 0; e < 4; ++e) { sp[e] = softplus_f(-p.lam[c + e]); ba[e] = p.ba[c + e]; bx[e] = p.bx[c + e]; }
        float A[4] = {1.f, 1.f, 1.f, 1.f}, H[4] = {0.f, 0.f, 0.f, 0.f};
        const int r0 = b * LP + ch * 64;
        for (int t = 0; t < 64; ++t) { float a[4], bb[4]; rg_ab(p, r0 + t, c, sp, ba, bx, a, bb);
#pragma unroll
            for (int e = 0; e < 4; ++e) { H[e] = a[e] * H[e] + bb[e]; A[e] *= a[e]; } }
        const size_t o = ((size_t)(b * 32 + ch)) * BR + c;
        *(GAS f32x4*)(CA + o) = (f32x4){A[0], A[1], A[2], A[3]}; *(GAS f32x4*)(CB + o) = (f32x4){H[0], H[1], H[2], H[3]};
    }
}
__device__ __forceinline__ void rg_scan_b(const Frame& F, const RgPar& p, const float* CA, const float* CB, const float* h0s, bf16* HG, float* outp, float* outs) {
    const int NP = BP * 32 * 512, NS = BS * 512;
    for (int it = F.gt; it < NP + NS; it += F.NGT) {
        int c, r0, nt; float H[4]; float* fin;
        if (it < NP) { c = (it & 511) * 4; const int ch = (it >> 9) & 31, b = it >> 14; r0 = b * LP + ch * 64; nt = 64;
            H[0] = H[1] = H[2] = H[3] = 0.f;
            for (int j = 0; j < ch; ++j) { const size_t o = ((size_t)(b * 32 + j)) * BR + c; const f32x4 Aj = *(const GAS f32x4*)(CA + o), Bj = *(const GAS f32x4*)(CB + o);
                H[0] = Aj.x * H[0] + Bj.x; H[1] = Aj.y * H[1] + Bj.y; H[2] = Aj.z * H[2] + Bj.z; H[3] = Aj.w * H[3] + Bj.w; }
            fin = (ch == 31) ? outp + (size_t)b * BR + c : nullptr;
        } else { const int is = it - NP; c = (is & 511) * 4; const int b = is >> 9; r0 = MP + b * LS; nt = LS;
            const f32x4 h0 = *(const GAS f32x4*)(h0s + (size_t)b * BR + c); H[0] = h0.x; H[1] = h0.y; H[2] = h0.z; H[3] = h0.w;
            fin = outs + (size_t)b * BR + c; }
        float sp[4], ba[4], bx[4];
#pragma unroll
        for (int e = 0; e < 4; ++e) { sp[e] = softplus_f(-p.lam[c + e]); ba[e] = p.ba[c + e]; bx[e] = p.bx[c + e]; }
        for (int t = 0; t < nt; ++t) { float a[4], bb[4]; const int r = r0 + t; rg_ab(p, r, c, sp, ba, bx, a, bb);
            const v2u gw = *(const GAS v2u*)(p.P + (size_t)r * 4096 + 2048 + c);
            const float gt[4] = {bflo(gw.x), bfhi(gw.x), bflo(gw.y), bfhi(gw.y)};
            float o[4];
#pragma unroll
            for (int e = 0; e < 4; ++e) { H[e] = a[e] * H[e] + bb[e]; o[e] = H[e] * silu_f(gt[e]); }
            v2u w; w.x = pk2(o[0], o[1]); w.y = pk2(o[2], o[3]); *(GAS v2u*)(HG + (size_t)r * BR + c) = w; }
        if (fin) *(GAS f32x4*)fin = (f32x4){H[0], H[1], H[2], H[3]};
    }
}

__device__ __forceinline__ int q_next(gu32* ctr, volatile LAS unsigned* slot, int tid) {
    __syncthreads();
    if (tid == 0) *slot = __hip_atomic_fetch_add(ctr, 1u, RLX_AGENT);
    __syncthreads();
    return (int)*slot;
}
typedef short bf16x4 __attribute__((ext_vector_type(4)));
__device__ __forceinline__ bf16x4 cvt4(const f32x4 v) { v2u w; w.x = pg8::cvt_pk_bf16(v.x, v.y); w.y = pg8::cvt_pk_bf16(v.z, v.w); return __builtin_bit_cast(bf16x4, w); }
#define MFMA16(a, b, c) __builtin_amdgcn_mfma_f32_16x16x16bf16_1k(a, b, c, 0, 0, 0)
#define MFMA32(a, b, c) __builtin_amdgcn_mfma_f32_16x16x32_bf16(a, b, c, 0, 0, 0)

__device__ __forceinline__ void ssd_dt_phase(const Frame& F, const bf16* P, const float* dt_bias, float* DT) {
    for (int it = F.gt; it < MT * SSD_H; it += F.NGT) { const int r = it >> 5, h = it & 31; DT[it] = softplus_f(bf2f(P[(size_t)r * SSD_NPAD + 6144 + h]) + dt_bias[h]); }
}
__device__ __forceinline__ void ssd_scan(const Frame& F, const bf16* XBC, const float* DT, const float* a_log, const float* s0s, float* YG, float* outs, gu32* qctr) {
    LAS float* Bs = (LAS float*)F.lds;
    LAS float* Cs = Bs + 8 * 128;
    LAS float* Xs = Cs + 8 * 128;
    LAS float* Ys = Xs + 8 * 64;
    LAS float* dts = Ys + 8 * 64;
    LAS float* dAs = dts + 8;
    const int tid = F.tid, p = tid >> 3, nq = tid & 7;
    for (;;) {
        const int su = q_next(qctr, (volatile LAS unsigned*)(F.lds + MISC_OFF + 64), tid);
        if (su >= BS * SSD_H) break;
        const int b = su >> 5, h = su & 31, row0 = MP + b * LS; float* sdst = outs + ((size_t)(b * SSD_H + h) * SSD_P + p) * SSD_N; float S[4][4];
        { const float* sp = s0s + ((size_t)(b * SSD_H + h) * SSD_P + p) * SSD_N;
#pragma unroll
          for (int i = 0; i < 4; ++i) { const f32x4 v = *(const GAS f32x4*)(sp + 32 * i + 4 * nq); S[i][0] = v.x; S[i][1] = v.y; S[i][2] = v.z; S[i][3] = v.w; } }
        const int g = h >> 2; const float ah = -expf(a_log[h]);
        if (tid < 128) { const int t = tid >> 4, v = tid & 15; const size_t ro = (size_t)(row0 + t) * SSD_CONV; float f[8];
            unpack8(*(const GAS v4u*)(XBC + ro + 2048 + g * 128 + 8 * v), f); *(LAS f32x4*)(Bs + t * 128 + 8 * v) = (f32x4){f[0], f[1], f[2], f[3]}; *(LAS f32x4*)(Bs + t * 128 + 8 * v + 4) = (f32x4){f[4], f[5], f[6], f[7]};
            unpack8(*(const GAS v4u*)(XBC + ro + 3072 + g * 128 + 8 * v), f); *(LAS f32x4*)(Cs + t * 128 + 8 * v) = (f32x4){f[0], f[1], f[2], f[3]}; *(LAS f32x4*)(Cs + t * 128 + 8 * v + 4) = (f32x4){f[4], f[5], f[6], f[7]}; }
        else if (tid < 192) { const int t = (tid - 128) >> 3, v = tid & 7; float f[8]; unpack8(*(const GAS v4u*)(XBC + (size_t)(row0 + t) * SSD_CONV + h * 64 + 8 * v), f);
            *(LAS f32x4*)(Xs + t * 64 + 8 * v) = (f32x4){f[0], f[1], f[2], f[3]}; *(LAS f32x4*)(Xs + t * 64 + 8 * v + 4) = (f32x4){f[4], f[5], f[6], f[7]}; }
        else if (tid < 200) { const int t = tid - 192; const float d = DT[(size_t)(row0 + t) * SSD_H + h]; dts[t] = d; dAs[t] = expf(d * ah); }
        __syncthreads();
#pragma unroll
        for (int t = 0; t < LS; ++t) {
            const float dA = dAs[t], xdt = Xs[t * 64 + p] * dts[t];
            float acc = 0.f;
#pragma unroll
            for (int i = 0; i < 4; ++i) { const f32x4 bv = *(const LAS f32x4*)(Bs + t * 128 + 32 * i + 4 * nq), cv = *(const LAS f32x4*)(Cs + t * 128 + 32 * i + 4 * nq);
                S[i][0] = dA * S[i][0] + xdt * bv.x; S[i][1] = dA * S[i][1] + xdt * bv.y; S[i][2] = dA * S[i][2] + xdt * bv.z; S[i][3] = dA * S[i][3] + xdt * bv.w;
                acc += (S[i][0] * cv.x + S[i][1] * cv.y) + (S[i][2] * cv.z + S[i][3] * cv.w); }
            acc += __shfl_xor(acc, 1); acc += __shfl_xor(acc, 2); acc += __shfl_xor(acc, 4);
            if (nq == 0) Ys[t * 64 + p] = acc;
        }
        __syncthreads();
        if (tid < 128) { const int t = tid >> 4, v4 = (tid & 15) * 4; *(GAS f32x4*)(YG + (size_t)(row0 + t) * BR + h * 64 + v4) = *(const LAS f32x4*)(Ys + t * 64 + v4); }
#pragma unroll
        for (int i = 0; i < 4; ++i) *(GAS f32x4*)(sdst + 32 * i + 4 * nq) = (f32x4){S[i][0], S[i][1], S[i][2], S[i][3]};
    }
}
constexpr int SSP_QP = 136;
constexpr int SSP_BM = 64 * SSP_QP * 2, SSP_BT = 2 * SSP_BM, SSP_XWT = SSP_BT + 16384, SSP_XDT = SSP_XWT + 8192, SSP_ACS = SSP_XDT + 8192, SSP_BUF = SSP_ACS + 256;
static_assert(2 * SSP_BUF <= LDSCTL_OFF, "ssd prompt LDS");
__device__ __forceinline__ void ssp_load_raw(const bf16* xbc_row, const float* dt_row, int g, int h, int ch, unsigned short (&rb)[16], unsigned short (&rc)[16], unsigned short (&rx)[16], float (&dt)[16]) {
#pragma unroll
    for (int t = 0; t < 16; ++t) { const GAS bf16* q = (const GAS bf16*)(xbc_row + (size_t)t * SSD_CONV); rb[t] = q[2048 + g * 128 + ch]; rc[t] = q[3072 + g * 128 + ch]; rx[t] = q[h * 64 + (ch & 63)]; dt[t] = ((const GAS float*)dt_row)[t * SSD_H + h]; }
}
__device__ __forceinline__ void ssp_stage(LAS unsigned char* buf, int blk, int ch, float ah, const unsigned short (&rb)[16], const unsigned short (&rc)[16], const unsigned short (&rx)[16], const float (&dt)[16]) {
    LAS bf16* CM = (LAS bf16*)buf; LAS bf16* BM = (LAS bf16*)(buf + SSP_BM);
#pragma unroll
    for (int t = 0; t < 16; ++t) { CM[(blk * 16 + t) * SSP_QP + ch] = rc[t]; BM[(blk * 16 + t) * SSP_QP + ch] = rb[t]; }
    v4u w0, w1;
    w0.x = rb[0] | ((unsigned)rb[1] << 16); w0.y = rb[2] | ((unsigned)rb[3] << 16); w0.z = rb[4] | ((unsigned)rb[5] << 16); w0.w = rb[6] | ((unsigned)rb[7] << 16);
    w1.x = rb[8] | ((unsigned)rb[9] << 16); w1.y = rb[10] | ((unsigned)rb[11] << 16); w1.z = rb[12] | ((unsigned)rb[13] << 16); w1.w = rb[14] | ((unsigned)rb[15] << 16);
    LAS v4u* bt = (LAS v4u*)(buf + SSP_BT + (blk * 128 + ch) * 32); bt[0] = w0; bt[1] = w1;
    if (ch < 64) {
        float acs[16]; float run = 0.f;
#pragma unroll
        for (int t = 0; t < 16; ++t) { run += dt[t] * ah; acs[t] = run; }
        float xd[16], xw[16];
#pragma unroll
        for (int t = 0; t < 16; ++t) { xd[t] = bf2f(rx[t]) * dt[t]; xw[t] = xd[t] * __expf(acs[15] - acs[t]); }
        w0.x = pk2(xw[0], xw[1]); w0.y = pk2(xw[2], xw[3]); w0.z = pk2(xw[4], xw[5]); w0.w = pk2(xw[6], xw[7]); w1.x = pk2(xw[8], xw[9]); w1.y = pk2(xw[10], xw[11]); w1.z = pk2(xw[12], xw[13]); w1.w = pk2(xw[14], xw[15]);
        LAS v4u* xwt = (LAS v4u*)(buf + SSP_XWT + (blk * 64 + ch) * 32); xwt[0] = w0; xwt[1] = w1;
        w0.x = pk2(xd[0], xd[1]); w0.y = pk2(xd[2], xd[3]); w0.z = pk2(xd[4], xd[5]); w0.w = pk2(xd[6], xd[7]); w1.x = pk2(xd[8], xd[9]); w1.y = pk2(xd[10], xd[11]); w1.z = pk2(xd[12], xd[13]); w1.w = pk2(xd[14], xd[15]);
        LAS v4u* xdt = (LAS v4u*)(buf + SSP_XDT + (blk * 64 + ch) * 32); xdt[0] = w0; xdt[1] = w1;
        if (ch == 0) { LAS float* A = (LAS float*)(buf + SSP_ACS) + blk * 16;
#pragma unroll
            for (int t = 0; t < 16; ++t) A[t] = acs[t]; }
    }
}
__device__ __forceinline__ void ssd_prompt(const Frame& F, const bf16* XBC, const float* DT, const float* a_log, float* YG, float* YG2, float* outp) {
    const int tid = F.tid, lane = F.lane, wave = F.wave, l15 = lane & 15, lq = lane >> 4;
    const int blk = tid >> 7, ch = tid & 127;
    for (int ui = blockIdx.x; ui < BP * SSD_H; ui += F.G) {
        const int b = ui >> 5, h = ui & 31, g = h >> 2; const size_t row0 = (size_t)b * LP;
        const float ah = -expf(a_log[h]);
        f32x4 S[8];
#pragma unroll
        for (int nb = 0; nb < 8; ++nb) S[nb] = (f32x4){0.f, 0.f, 0.f, 0.f};
        unsigned short rb[16], rc[16], rx[16]; float dt[16];
        const bf16* xrow = XBC + (row0 + blk * 16) * SSD_CONV; const float* dtrow = DT + (row0 + blk * 16) * SSD_H;
        ssp_load_raw(xrow, dtrow, g, h, ch, rb, rc, rx, dt);
        __syncthreads();
        ssp_stage(F.lds, blk, ch, ah, rb, rc, rx, dt);
        __syncthreads();
        for (int st = 0; st < LP / 64; ++st) {
            LAS unsigned char* buf = F.lds + (st & 1) * SSP_BUF;
            if (st + 1 < LP / 64) ssp_load_raw(xrow + (size_t)(st + 1) * 64 * SSD_CONV, dtrow + (size_t)(st + 1) * 64 * SSD_H, g, h, ch, rb, rc, rx, dt);
            const LAS bf16* CM = (const LAS bf16*)buf; const LAS bf16* BM = (const LAS bf16*)(buf + SSP_BM); const LAS float* ACS = (const LAS float*)(buf + SSP_ACS);
            if (wave < 4) {
                const int pb = wave;
#pragma unroll 1
                for (int bk = 0; bk < 4; ++bk) {
                    const LAS bf16* crow = CM + (bk * 16 + l15) * SSP_QP;
                    f32x4 yo = (f32x4){0.f, 0.f, 0.f, 0.f};
#pragma unroll
                    for (int nb = 0; nb < 8; ++nb) yo = MFMA16(cvt4(S[nb]), *(const LAS bf16x4*)(crow + nb * 16 + 4 * lq), yo);
                    const float ea = __expf(ACS[bk * 16 + l15]);
                    *(GAS f32x4*)(YG + (row0 + st * 64 + bk * 16 + l15) * BR + h * 64 + 16 * pb + 4 * lq) = yo * ea;
                    const float dab = __expf(ACS[bk * 16 + 15]);
                    const bf16x4 xw = *(const LAS bf16x4*)(buf + SSP_XWT + ((bk * 64 + 16 * pb + l15) * 16 + 4 * lq) * 2);
#pragma unroll
                    for (int nb = 0; nb < 8; ++nb) S[nb] = MFMA16(*(const LAS bf16x4*)(buf + SSP_BT + ((bk * 128 + nb * 16 + l15) * 16 + 4 * lq) * 2), xw, S[nb] * dab);
                }
            } else {
                const int bk = wave - 4;
                const LAS bf16* crow = CM + (bk * 16 + l15) * SSP_QP; const LAS bf16* brow = BM + (bk * 16 + l15) * SSP_QP;
                f32x4 gt = (f32x4){0.f, 0.f, 0.f, 0.f};
#pragma unroll
                for (int ks = 0; ks < 4; ++ks) gt = MFMA32(*(const LAS bf16x8*)(brow + ks * 32 + 8 * lq), *(const LAS bf16x8*)(crow + ks * 32 + 8 * lq), gt);
                const float at = ACS[bk * 16 + l15]; const f32x4 as = *(const LAS f32x4*)(ACS + bk * 16 + 4 * lq);
                gt.x = (4 * lq + 0 <= l15) ? gt.x * __expf(at - as.x) : 0.f; gt.y = (4 * lq + 1 <= l15) ? gt.y * __expf(at - as.y) : 0.f;
                gt.z = (4 * lq + 2 <= l15) ? gt.z * __expf(at - as.z) : 0.f; gt.w = (4 * lq + 3 <= l15) ? gt.w * __expf(at - as.w) : 0.f;
                const bf16x4 lb4 = cvt4(gt);
#pragma unroll
                for (int pb = 0; pb < 4; ++pb) { const f32x4 yd = MFMA16(*(const LAS bf16x4*)(buf + SSP_XDT + ((bk * 64 + 16 * pb + l15) * 16 + 4 * lq) * 2), lb4, ((f32x4){0.f, 0.f, 0.f, 0.f}));
                    *(GAS f32x4*)(YG2 + (row0 + st * 64 + bk * 16 + l15) * BR + h * 64 + 16 * pb + 4 * lq) = yd; }
            }
            if (st + 1 < LP / 64) ssp_stage(F.lds + ((st + 1) & 1) * SSP_BUF, blk, ch, ah, rb, rc, rx, dt);
            __syncthreads();
        }
        if (wave < 4) { float* sd = outp + ((size_t)(b * SSD_H + h) * SSD_P + 16 * wave + l15) * SSD_N + 4 * lq;
#pragma unroll
            for (int nb = 0; nb < 8; ++nb) *(GAS f32x4*)(sd + nb * 16) = S[nb]; }
    }
}
__device__ __forceinline__ void ssd_norm(const Frame& F, const float* YG, const float* YG2, const bf16* XBC, const bf16* P, const float* dsk, bf16* HG) {
    for (int r = F.gw; r < MT; r += F.NGW) {
        const GAS f32x4* yr = (const GAS f32x4*)(YG + (size_t)r * BR) + F.lane; const GAS f32x4* y2 = (const GAS f32x4*)(YG2 + (size_t)r * BR) + F.lane; GAS v2u* o8 = (GAS v2u*)(HG + (size_t)r * BR) + F.lane;
        const GAS v2u* x8 = (const GAS v2u*)(XBC + (size_t)r * SSD_CONV) + F.lane; const GAS v2u* z8 = (const GAS v2u*)(P + (size_t)r * SSD_NPAD) + F.lane;
#pragma unroll
        for (int j = 0; j < 8; ++j) { f32x4 v = yr[64 * j]; if (r < MP) v = v + y2[64 * j];
            const float Dh = dsk[(256 * j + 4 * F.lane) >> 6]; const v2u xw = x8[64 * j], zw = z8[64 * j];
            v.x = (v.x + Dh * bflo(xw.x)) * silu_f(bflo(zw.x)); v.y = (v.y + Dh * bfhi(xw.x)) * silu_f(bfhi(zw.x)); v.z = (v.z + Dh * bflo(xw.y)) * silu_f(bflo(zw.y)); v.w = (v.w + Dh * bfhi(xw.y)) * silu_f(bfhi(zw.y));
            const float sq = wave_sum((v.x * v.x + v.y * v.y) + (v.z * v.z + v.w * v.w)); const float rstd = 1.0f / sqrtf(sq * (1.f / 256.f) + EPS);
            v2u w; w.x = pk2(v.x * rstd, v.y * rstd); w.y = pk2(v.z * rstd, v.w * rstd); o8[64 * j] = w; }
    }
}

constexpr int HGP_QP = 136;
constexpr int HGP_KG = 64 * HGP_QP * 2, HGP_KDT = 2 * HGP_KG, HGP_VT = HGP_KDT + 16384, HGP_GL = HGP_VT + 16384, HGP_BUF = HGP_GL + 2048;
static_assert(2 * HGP_BUF <= LDSCTL_OFF, "hgrn prompt LDS");
__device__ __forceinline__ void hgp_load_raw(const bf16* p, unsigned short (&rq)[16], unsigned short (&rf)[16], unsigned short (&rv)[16]) {
#pragma unroll
    for (int t = 0; t < 16; ++t) { const GAS bf16* q = (const GAS bf16*)(p + (size_t)t * 8192); rq[t] = q[0]; rf[t] = q[2048]; rv[t] = q[4096]; }
}
__device__ __forceinline__ void hgp_stage(LAS unsigned char* buf, int blk, int ch, float lb, const unsigned short (&rq)[16], const unsigned short (&rf)[16], const unsigned short (&rv)[16]) {
    float G[16], kk[16]; float run = 0.f; const float omlb = 1.0f - lb;
#pragma unroll
    for (int t = 0; t < 16; ++t) { const float sg = sigmoid_f(bf2f(rf[t])); const float fo = lb + omlb * sg; run += __logf(fo); G[t] = run; kk[t] = omlb * (1.0f - sg); }
    LAS bf16* QG = (LAS bf16*)buf; LAS bf16* KG = (LAS bf16*)(buf + HGP_KG);
    float kd[16];
#pragma unroll
    for (int t = 0; t < 16; ++t) { const float e = __expf(G[t]); const float qg = silu_f(bf2f(rq[t])) * e; const float kg = kk[t] * __expf(-G[t]); kd[t] = kk[t] * __expf(G[15] - G[t]);
        QG[(blk * 16 + t) * HGP_QP + ch] = (bf16)f2bf(qg); KG[(blk * 16 + t) * HGP_QP + ch] = (bf16)f2bf(kg); }
    v4u w0, w1;
    w0.x = pk2(kd[0], kd[1]); w0.y = pk2(kd[2], kd[3]); w0.z = pk2(kd[4], kd[5]); w0.w = pk2(kd[6], kd[7]); w1.x = pk2(kd[8], kd[9]); w1.y = pk2(kd[10], kd[11]); w1.z = pk2(kd[12], kd[13]); w1.w = pk2(kd[14], kd[15]);
    LAS v4u* kdt = (LAS v4u*)(buf + HGP_KDT + (blk * 128 + ch) * 32); kdt[0] = w0; kdt[1] = w1;
    w0.x = rv[0] | ((unsigned)rv[1] << 16); w0.y = rv[2] | ((unsigned)rv[3] << 16); w0.z = rv[4] | ((unsigned)rv[5] << 16); w0.w = rv[6] | ((unsigned)rv[7] << 16);
    w1.x = rv[8] | ((unsigned)rv[9] << 16); w1.y = rv[10] | ((unsigned)rv[11] << 16); w1.z = rv[12] | ((unsigned)rv[13] << 16); w1.w = rv[14] | ((unsigned)rv[15] << 16);
    LAS v4u* vt = (LAS v4u*)(buf + HGP_VT + (blk * 128 + ch) * 32); vt[0] = w0; vt[1] = w1;
    ((LAS float*)(buf + HGP_GL))[blk * 128 + ch] = __expf(G[15]);
}
__device__ __forceinline__ void hgrn_prompt(const Frame& F, const bf16* P, const float* LBl, float* OH, float* outp) {
    const int tid = F.tid, lane = F.lane, wave = F.wave, l15 = lane & 15, lq = lane >> 4;
    const int blk = tid >> 7, ch = tid & 127;
    for (int ui = blockIdx.x; ui < BP * HG_H; ui += F.G) {
        const int b = ui >> 4, h = ui & 15; const size_t row0 = (size_t)b * LP;
        const float lb = LBl[h * 128 + ch];
        f32x4 S[8];
#pragma unroll
        for (int kb = 0; kb < 8; ++kb) S[kb] = (f32x4){0.f, 0.f, 0.f, 0.f};
        unsigned short rq[16], rf[16], rv[16];
        const bf16* pbase = P + (row0 + blk * 16) * 8192 + h * 128 + ch;
        hgp_load_raw(pbase, rq, rf, rv);
        __syncthreads();
        hgp_stage(F.lds, blk, ch, lb, rq, rf, rv);
        __syncthreads();
        for (int st = 0; st < LP / 64; ++st) {
            LAS unsigned char* buf = F.lds + (st & 1) * HGP_BUF;
            if (st + 1 < LP / 64) hgp_load_raw(pbase + (size_t)(st + 1) * 64 * 8192, rq, rf, rv);
            const LAS bf16* QG = (const LAS bf16*)buf; const LAS bf16* KG = (const LAS bf16*)(buf + HGP_KG);
#pragma unroll 1
            for (int bk = 0; bk < 4; ++bk) {
                const LAS bf16* qrow = QG + (bk * 16 + l15) * HGP_QP; const LAS bf16* krow = KG + (bk * 16 + l15) * HGP_QP;
                f32x4 at = (f32x4){0.f, 0.f, 0.f, 0.f};
#pragma unroll
                for (int ks = 0; ks < 4; ++ks) at = MFMA32(*(const LAS bf16x8*)(krow + ks * 32 + 8 * lq), *(const LAS bf16x8*)(qrow + ks * 32 + 8 * lq), at);
                at.x = (4 * lq + 0 <= l15) ? at.x : 0.f; at.y = (4 * lq + 1 <= l15) ? at.y : 0.f; at.z = (4 * lq + 2 <= l15) ? at.z : 0.f; at.w = (4 * lq + 3 <= l15) ? at.w : 0.f;
                const bf16x4 attb = cvt4(at);
                f32x4 o = (f32x4){0.f, 0.f, 0.f, 0.f};
#pragma unroll
                for (int kb = 0; kb < 8; ++kb) o = MFMA16(cvt4(S[kb]), *(const LAS bf16x4*)(qrow + kb * 16 + 4 * lq), o);
                const bf16x4 vfrag = *(const LAS bf16x4*)(buf + HGP_VT + ((bk * 128 + 16 * wave + l15) * 16 + 4 * lq) * 2);
                o = MFMA16(vfrag, attb, o);
                *(GAS f32x4*)(OH + (row0 + st * 64 + bk * 16 + l15) * BR + h * 128 + 16 * wave + 4 * lq) = o;
#pragma unroll
                for (int kb = 0; kb < 8; ++kb) { const f32x4 gl = *(const LAS f32x4*)(buf + HGP_GL + (bk * 128 + kb * 16 + 4 * lq) * 4);
                    S[kb] = MFMA16(*(const LAS bf16x4*)(buf + HGP_KDT + ((bk * 128 + kb * 16 + l15) * 16 + 4 * lq) * 2), vfrag, S[kb] * gl); }
            }
            if (st + 1 < LP / 64) hgp_stage(F.lds + ((st + 1) & 1) * HGP_BUF, blk, ch, lb, rq, rf, rv);
            __syncthreads();
        }
        float* sd = outp + ((size_t)(b * HG_H + h) * HG_DK) * HG_DV + 16 * wave + l15;
#pragma unroll
        for (int kb = 0; kb < 8; ++kb) { sd[(size_t)(kb * 16 + 4 * lq + 0) * HG_DV] = S[kb].x; sd[(size_t)(kb * 16 + 4 * lq + 1) * HG_DV] = S[kb].y; sd[(size_t)(kb * 16 + 4 * lq + 2) * HG_DV] = S[kb].z; sd[(size_t)(kb * 16 + 4 * lq + 3) * HG_DV] = S[kb].w; }
    }
}
__device__ __forceinline__ void hgrn_scan(const Frame& F, const bf16* P, const float* LBl, const float* s0s, float* OH, float* outs, gu32* qctr) {
    LAS float* Fs = (LAS float*)F.lds;
    LAS float* Ks = Fs + 32 * 128;
    LAS float* Qs = Ks + 32 * 128;
    LAS float* Vs = Qs + 32 * 128;
    LAS float* Pt = Vs + 32 * 64;
    const int tid = F.tid, dvq = tid & 15, dkq = tid >> 4, wave = F.wave, lane = F.lane;
    for (;;) {
        const int su = q_next(qctr, (volatile LAS unsigned*)(F.lds + MISC_OFF + 64), tid);
        if (su >= BS * HG_H * 2) break;
        int b, h, half, L, row0; float* sdst; float S[4][4];
        { b = su >> 5; h = (su >> 1) & 15; half = su & 1; L = LS; row0 = MP + b * LS; sdst = outs;
#pragma unroll
            for (int i = 0; i < 4; ++i) { const f32x4 v = *(const GAS f32x4*)(s0s + ((size_t)(b * HG_H + h) * HG_DK + 4 * dkq + i) * HG_DV + half * 64 + 4 * dvq); S[i][0] = v.x; S[i][1] = v.y; S[i][2] = v.z; S[i][3] = v.w; }
        }
        sdst += ((size_t)(b * HG_H + h) * HG_DK + 4 * dkq) * HG_DV + half * 64 + 4 * dvq;
        for (int c0 = 0; c0 < L; c0 += 32) {
            const int tn = (L - c0) < 32 ? (L - c0) : 32;
            { const int t = tid >> 4, v = tid & 15;
              if (t < tn) { const size_t ro = (size_t)(row0 + c0 + t) * 8192; float q[8], f[8];
                  unpack8(*(const GAS v4u*)(P + ro + h * 128 + 8 * v), q); unpack8(*(const GAS v4u*)(P + ro + 2048 + h * 128 + 8 * v), f);
                  float fo[8], ko[8], qo[8];
#pragma unroll
                  for (int e = 0; e < 8; ++e) { const float lb = LBl[h * 128 + 8 * v + e]; const float sg = sigmoid_f(f[e]); fo[e] = lb + (1.0f - lb) * sg; ko[e] = (1.0f - lb) * (1.0f - sg); qo[e] = silu_f(q[e]); }
                  *(LAS f32x4*)(Fs + t * 128 + 8 * v) = (f32x4){fo[0], fo[1], fo[2], fo[3]}; *(LAS f32x4*)(Fs + t * 128 + 8 * v + 4) = (f32x4){fo[4], fo[5], fo[6], fo[7]};
                  *(LAS f32x4*)(Ks + t * 128 + 8 * v) = (f32x4){ko[0], ko[1], ko[2], ko[3]}; *(LAS f32x4*)(Ks + t * 128 + 8 * v + 4) = (f32x4){ko[4], ko[5], ko[6], ko[7]};
                  *(LAS f32x4*)(Qs + t * 128 + 8 * v) = (f32x4){qo[0], qo[1], qo[2], qo[3]}; *(LAS f32x4*)(Qs + t * 128 + 8 * v + 4) = (f32x4){qo[4], qo[5], qo[6], qo[7]}; } }
            if (tid < 256) { const int t = tid >> 3, v = tid & 7;
              if (t < tn) { float f[8]; unpack8(*(const GAS v4u*)(P + (size_t)(row0 + c0 + t) * 8192 + 4096 + h * 128 + half * 64 + 8 * v), f);
                  *(LAS f32x4*)(Vs + t * 64 + 8 * v) = (f32x4){f[0], f[1], f[2], f[3]}; *(LAS f32x4*)(Vs + t * 64 + 8 * v + 4) = (f32x4){f[4], f[5], f[6], f[7]}; } }
            __syncthreads();
            for (int t = 0; t < tn; ++t) {
                const f32x4 fv = *(const LAS f32x4*)(Fs + t * 128 + 4 * dkq), kv = *(const LAS f32x4*)(Ks + t * 128 + 4 * dkq), qv = *(const LAS f32x4*)(Qs + t * 128 + 4 * dkq), vv = *(const LAS f32x4*)(Vs + t * 64 + 4 * dvq);
                const float ff[4] = {fv.x, fv.y, fv.z, fv.w}, kk[4] = {kv.x, kv.y, kv.z, kv.w}, qq[4] = {qv.x, qv.y, qv.z, qv.w};
                float acc[4] = {0.f, 0.f, 0.f, 0.f};
#pragma unroll
                for (int i = 0; i < 4; ++i) { S[i][0] = ff[i] * S[i][0] + kk[i] * vv.x; S[i][1] = ff[i] * S[i][1] + kk[i] * vv.y; S[i][2] = ff[i] * S[i][2] + kk[i] * vv.z; S[i][3] = ff[i] * S[i][3] + kk[i] * vv.w;
                    acc[0] += qq[i] * S[i][0]; acc[1] += qq[i] * S[i][1]; acc[2] += qq[i] * S[i][2]; acc[3] += qq[i] * S[i][3]; }
#pragma unroll
                for (int e = 0; e < 4; ++e) { acc[e] += __shfl_xor(acc[e], 16); acc[e] += __shfl_xor(acc[e], 32); }
                if (lane < 16) *(LAS f32x4*)(Pt + (t * 8 + wave) * 64 + 4 * dvq) = (f32x4){acc[0], acc[1], acc[2], acc[3]};
            }
            __syncthreads();
            { const int t = tid >> 4, d4 = (tid & 15) * 4;
              if (t < tn) { f32x4 s = (f32x4){0.f, 0.f, 0.f, 0.f};
#pragma unroll
                  for (int w = 0; w < 8; ++w) s = s + *(const LAS f32x4*)(Pt + (t * 8 + w) * 64 + d4);
                  *(GAS f32x4*)(OH + (size_t)(row0 + c0 + t) * BR + h * 128 + half * 64 + d4) = s; } }
            __syncthreads();
        }
#pragma unroll
        for (int i = 0; i < 4; ++i) *(GAS f32x4*)(sdst + (size_t)i * HG_DV) = (f32x4){S[i][0], S[i][1], S[i][2], S[i][3]};
    }
}
__device__ __forceinline__ void hgrn_norm(const Frame& F, const float* OH, const bf16* P, bf16* HG) {
    for (int r = F.gw; r < MT; r += F.NGW) {
        const GAS f32x4* orow = (const GAS f32x4*)(OH + (size_t)r * BR) + F.lane; GAS v2u* o8 = (GAS v2u*)(HG + (size_t)r * BR) + F.lane;
        const GAS v2u* g8 = (const GAS v2u*)(P + (size_t)r * 8192 + 6144) + F.lane;
#pragma unroll
        for (int j = 0; j < 8; ++j) { const f32x4 v = orow[64 * j]; float s = (v.x * v.x + v.y * v.y) + (v.z * v.z + v.w * v.w);
            s += __shfl_xor(s, 1); s += __shfl_xor(s, 2); s += __shfl_xor(s, 4); s += __shfl_xor(s, 8); s += __shfl_xor(s, 16);
            const float rstd = 1.0f / sqrtf(s * (1.f / 128.f) + EPS); const v2u gw = g8[64 * j];
            v2u w; w.x = pk2(v.x * rstd * silu_f(bflo(gw.x)), v.y * rstd * silu_f(bfhi(gw.x))); w.y = pk2(v.z * rstd * silu_f(bflo(gw.y)), v.w * rstd * silu_f(bfhi(gw.y))); o8[64 * j] = w; }
    }
}

struct RgF { const bf16* P; const bf16* Wax; const float* cw; const float* cb; const float* ba; const float* bx; const float* lam; const float* st_conv; const float* st_h;
             bf16* HG; float* rgc_p; float* rgc_s; float* rgh_p; float* rgh_s; };
constexpr int RGF_UP = 264, RGF_LGP = 132;
constexpr int RGF_LG = 64 * RGF_UP * 2, RGF_SEG = RGF_LG + 64 * RGF_LGP * 4, RGF_HC = RGF_SEG + 8 * 64 * 2 * 4;
__device__ __forceinline__ void rgf_load_raw(const RgF& p, int sample, int bt, int tile, int tq, size_t row0, int colb, v4u (&raw)[7]) {
#pragma unroll
    for (int m = 0; m < 7; ++m) {
        const int tl = tile * 64 + 4 * tq - 3 + m;
        if (sample && !(tq & 1) && m < 3) { const float* sp = p.st_conv + ((size_t)(bt * 8 + (tq >> 1)) * 3 + m) * BR + colb; const f32x4 s0 = *(const GAS f32x4*)sp, s1 = *(const GAS f32x4*)(sp + 4);
            raw[m].x = pk2(s0.x, s0.y); raw[m].y = pk2(s0.z, s0.w); raw[m].z = pk2(s1.x, s1.y); raw[m].w = pk2(s1.z, s1.w); }
        else if (tl >= 0) raw[m] = *(const GAS v4u*)(p.P + (row0 + tl) * 4096 + colb);
        else raw[m] = (v4u){0u, 0u, 0u, 0u};
    }
}
__device__ __forceinline__ void rg_fused(const Frame& F, const RgF& p, gu32* qctr) {
    LAS bf16* UC = (LAS bf16*)F.lds; LAS float* LG = (LAS float*)(F.lds + RGF_LG); LAS float* SEG = (LAS float*)(F.lds + RGF_SEG); LAS float* HC = (LAS float*)(F.lds + RGF_HC);
    const int tid = F.tid, lane = F.lane, wave = F.wave, l15 = lane & 15, lq = lane >> 4;
    const int tq = tid >> 5, v = tid & 31, c = tid & 63, sg = wave;
    int ui = blockIdx.x;
    for (;;) {
        int sample, bt, slice;
        if (ui < BP * 32) { sample = 0; bt = ui >> 5; slice = ui & 31; ui += F.G; }
        else { const int su = q_next(qctr, (volatile LAS unsigned*)(F.lds + MISC_OFF + 64), tid); if (su >= 16 * 32) break; sample = 1; bt = su >> 5; slice = su & 31; }
        const int j = slice >> 2, sq = slice & 3, chan = slice * 64 + c, colb = 256 * j + 8 * v;
        const int ntile = sample ? 1 : LP / 64; const size_t row0 = sample ? (size_t)MP + (size_t)bt * 64 : (size_t)bt * LP;
        float cw0[8], cw1[8], cw2[8], cw3[8], cbs[8];
#pragma unroll
        for (int e = 0; e < 8; ++e) { cw0[e] = p.cw[0 * BR + colb + e]; cw1[e] = p.cw[1 * BR + colb + e]; cw2[e] = p.cw[2 * BR + colb + e]; cw3[e] = p.cw[3 * BR + colb + e]; cbs[e] = p.cb[colb + e]; }
        bf16x8 Wf[8];
        { const bf16* wr = p.Wax + (size_t)(512 * j + (wave >> 2) * 256 + sq * 64 + 16 * (wave & 3) + l15) * 256 + 8 * lq;
#pragma unroll
          for (int ks = 0; ks < 8; ++ks) Wf[ks] = *(const GAS bf16x8*)(wr + ks * 32); }
        const float sp = softplus_f(-p.lam[chan]), ba = p.ba[chan], bx = p.bx[chan];
        v4u raw[7];
        rgf_load_raw(p, sample, bt, 0, tq, row0, colb, raw);
        __syncthreads();
        if (tid < 64) HC[tid] = 0.f;
        for (int tile = 0; tile < ntile; ++tile) {
            float u[7][8];
#pragma unroll
            for (int m = 0; m < 7; ++m) unpack8(raw[m], u[m]);
#pragma unroll
            for (int i = 0; i < 4; ++i) { float o[8];
#pragma unroll
                for (int e = 0; e < 8; ++e) o[e] = cbs[e] + cw0[e] * u[i][e] + cw1[e] * u[i + 1][e] + cw2[e] * u[i + 2][e] + cw3[e] * u[i + 3][e];
                *(LAS v4u*)(UC + (4 * tq + i) * RGF_UP + 8 * v) = pack8(o); }
            if ((v >> 3) == sq && (sample ? (tq & 1) : (tile == ntile - 1 && tq == 15))) {
                float* dst = sample ? p.rgc_s + ((size_t)(bt * 8 + (tq >> 1)) * 3) * BR + colb : p.rgc_p + ((size_t)bt * 3) * BR + colb;
#pragma unroll
                for (int i = 1; i < 4; ++i) { *(GAS f32x4*)(dst + (size_t)(i - 1) * BR) = (f32x4){u[i + 3][0], u[i + 3][1], u[i + 3][2], u[i + 3][3]}; *(GAS f32x4*)(dst + (size_t)(i - 1) * BR + 4) = (f32x4){u[i + 3][4], u[i + 3][5], u[i + 3][6], u[i + 3][7]}; } }
            __syncthreads();
            if (tile + 1 < ntile) rgf_load_raw(p, sample, bt, tile + 1, tq, row0, colb, raw);
            const size_t rseg = row0 + tile * 64 + 8 * sg;
            unsigned short gt[8];
#pragma unroll
            for (int tt = 0; tt < 8; ++tt) gt[tt] = *(const GAS bf16*)(p.P + (rseg + tt) * 4096 + 2048 + chan);
#pragma unroll
            for (int rb = 0; rb < 4; ++rb) { f32x4 acc = (f32x4){0.f, 0.f, 0.f, 0.f};
#pragma unroll
                for (int ks = 0; ks < 8; ++ks) acc = MFMA32(*(const LAS bf16x8*)(UC + (16 * rb + l15) * RGF_UP + ks * 32 + 8 * lq), Wf[ks], acc);
                LAS float* lg = LG + (16 * rb + 4 * lq) * RGF_LGP + 16 * wave + l15; lg[0] = acc.x; lg[RGF_LGP] = acc.y; lg[2 * RGF_LGP] = acc.z; lg[3 * RGF_LGP] = acc.w; }
            __syncthreads();
            float a_[8], b_[8]; float As = 1.f, Hs = 0.f;
#pragma unroll
            for (int tt = 0; tt < 8; ++tt) { const int t = 8 * sg + tt; const float la = LG[t * RGF_LGP + c] + ba, lx = LG[t * RGF_LGP + 64 + c] + bx; const float uu = bf2f(UC[t * RGF_UP + sq * 64 + c]);
                const float rr = sigmoid_f(la), ii = sigmoid_f(lx); const float a = __expf(-8.0f * rr * sp); const float bb = sqrtf(fmaxf(1.0f - a * a, 0.f)) * (ii * uu);
                a_[tt] = a; b_[tt] = bb; As *= a; Hs = a * Hs + bb; }
            SEG[(sg * 64 + c) * 2] = As; SEG[(sg * 64 + c) * 2 + 1] = Hs;
            __syncthreads();
            float h;
            if (sample) h = p.st_h[(size_t)(bt * 8 + sg) * BR + chan];
            else { h = HC[(tile & 1) * 64 + c];
                for (int jj = 0; jj < sg; ++jj) h = SEG[(jj * 64 + c) * 2] * h + SEG[(jj * 64 + c) * 2 + 1]; }
#pragma unroll
            for (int tt = 0; tt < 8; ++tt) { h = a_[tt] * h + b_[tt]; *(GAS bf16*)(p.HG + (rseg + tt) * BR + chan) = (bf16)f2bf(h * silu_f(bf2f(gt[tt]))); }
            if (sample) p.rgh_s[(size_t)(bt * 8 + sg) * BR + chan] = h;
            else if (sg == 7) { HC[((tile + 1) & 1) * 64 + c] = h; if (tile == ntile - 1) p.rgh_p[(size_t)bt * BR + chan] = h; }
        }
    }
}

__device__ __forceinline__ void attn_prompt(const Frame& F, const bf16* Q, const bf16* KP, const bf16* VT, bf16* O) {
    const int lane = F.lane, l15 = lane & 15, lq = lane >> 4;
    for (int ui = blockIdx.x; ui < BP * 4 * 16; ui += F.G) {
        const int qt = ui & 15, h = (ui >> 4) & 3, b = ui >> 6;
        const int r0 = b * LP + qt * 128 + F.wave * 16;
        bf16x8 Qb[8];
#pragma unroll
        for (int ks = 0; ks < 8; ++ks) Qb[ks] = *(const GAS bf16x8*)(Q + (size_t)(r0 + l15) * DM + h * 256 + ks * 32 + 8 * lq);
        f32x4 ST[16];
        const bf16* kb_base = KP + (size_t)(b * NMEM + l15) * DM + h * 256 + 8 * lq;
#pragma unroll
        for (int kb = 0; kb < 16; ++kb) { f32x4 acc = (f32x4){0.f, 0.f, 0.f, 0.f};
#pragma unroll
            for (int ks = 0; ks < 8; ++ks) { const bf16x8 Ka = *(const GAS bf16x8*)(kb_base + (size_t)(kb * 16) * DM + ks * 32); acc = __builtin_amdgcn_mfma_f32_16x16x32_bf16(Ka, Qb[ks], acc, 0, 0, 0); }
            ST[kb] = acc; }
        float mx = -3.0e38f;
#pragma unroll
        for (int kb = 0; kb < 16; ++kb) mx = fmaxf(mx, fmaxf(fmaxf(ST[kb].x, ST[kb].y), fmaxf(ST[kb].z, ST[kb].w)));
        mx = fmaxf(mx, __shfl_xor(mx, 16)); mx = fmaxf(mx, __shfl_xor(mx, 32));
        float sum = 0.f;
#pragma unroll
        for (int kb = 0; kb < 16; ++kb) { ST[kb].x = __expf(ST[kb].x - mx); ST[kb].y = __expf(ST[kb].y - mx); ST[kb].z = __expf(ST[kb].z - mx); ST[kb].w = __expf(ST[kb].w - mx); sum += (ST[kb].x + ST[kb].y) + (ST[kb].z + ST[kb].w); }
        sum += __shfl_xor(sum, 16); sum += __shfl_xor(sum, 32);
        const float inv = 1.0f / sum;
        bf16x8 Pb[8];
#pragma unroll
        for (int s = 0; s < 8; ++s) { v4u w; w.x = pk2(ST[2 * s].x, ST[2 * s].y); w.y = pk2(ST[2 * s].z, ST[2 * s].w); w.z = pk2(ST[2 * s + 1].x, ST[2 * s + 1].y); w.w = pk2(ST[2 * s + 1].z, ST[2 * s + 1].w); Pb[s] = __builtin_bit_cast(bf16x8, w); }
        const bf16* vt_base = VT + (size_t)(h * 256 + l15) * 2048 + b * NMEM + 4 * lq;
#pragma unroll 4
        for (int db = 0; db < 16; ++db) { f32x4 acc = (f32x4){0.f, 0.f, 0.f, 0.f};
#pragma unroll
            for (int s = 0; s < 8; ++s) { const bf16* vp = vt_base + (size_t)(db * 16) * 2048 + 32 * s; const v2u lo = *(const GAS v2u*)vp, hi = *(const GAS v2u*)(vp + 16);
                v4u w; w.x = lo.x; w.y = lo.y; w.z = hi.x; w.w = hi.y; acc = __builtin_amdgcn_mfma_f32_16x16x32_bf16(__builtin_bit_cast(bf16x8, w), Pb[s], acc, 0, 0, 0); }
            v2u w; w.x = pk2(acc.x * inv, acc.y * inv); w.y = pk2(acc.z * inv, acc.w * inv);
            *(GAS v2u*)(O + (size_t)(r0 + l15) * DM + h * 256 + db * 16 + 4 * lq) = w; }
    }
}
__device__ __forceinline__ void attn_sample(const Frame& F, const bf16* Q, const float* CK, const float* CV, bf16* O) {
    LAS float* redm = (LAS float*)F.lds;
    LAS float* reds = redm + 64;
    LAS float* Pl = reds + 64;
    LAS float* Ored = Pl + 8 * 256;
    const int lane = F.lane, l15 = lane & 15, lq = lane >> 4, wave = F.wave, tid = F.tid;
    for (int ui = blockIdx.x; ui < BS * 4; ui += F.G) {
        const int h = ui & 3, b = ui >> 2;
        bf16x8 Qb[8];
#pragma unroll
        for (int ks = 0; ks < 8; ++ks) { v4u w = (v4u){0u, 0u, 0u, 0u}; if (l15 < 8) w = *(const GAS v4u*)(Q + (size_t)(MP + b * LS + l15) * DM + h * 256 + ks * 32 + 8 * lq); Qb[ks] = __builtin_bit_cast(bf16x8, w); }
        f32x4 ST[2];
#pragma unroll
        for (int kb = 0; kb < 2; ++kb) { f32x4 acc = (f32x4){0.f, 0.f, 0.f, 0.f};
            const float* kp = CK + ((size_t)(b * NMEM + wave * 32 + kb * 16 + l15)) * DM + h * 256 + 8 * lq;
#pragma unroll
            for (int ks = 0; ks < 8; ++ks) { const f32x4 k0 = *(const GAS f32x4*)(kp + ks * 32), k1 = *(const GAS f32x4*)(kp + ks * 32 + 4);
                v4u w; w.x = pk2(k0.x, k0.y); w.y = pk2(k0.z, k0.w); w.z = pk2(k1.x, k1.y); w.w = pk2(k1.z, k1.w);
                acc = __builtin_amdgcn_mfma_f32_16x16x32_bf16(__builtin_bit_cast(bf16x8, w), Qb[ks], acc, 0, 0, 0); }
            ST[kb] = acc; }
        float mx = fmaxf(fmaxf(fmaxf(ST[0].x, ST[0].y), fmaxf(ST[0].z, ST[0].w)), fmaxf(fmaxf(ST[1].x, ST[1].y), fmaxf(ST[1].z, ST[1].w)));
        mx = fmaxf(mx, __shfl_xor(mx, 16)); mx = fmaxf(mx, __shfl_xor(mx, 32));
        if (lane < 8) redm[wave * 8 + lane] = mx;
        __syncthreads();
        float gm = -3.0e38f;
#pragma unroll
        for (int w = 0; w < 8; ++w) gm = fmaxf(gm, redm[w * 8 + (l15 & 7)]);
        float sum = 0.f;
#pragma unroll
        for (int kb = 0; kb < 2; ++kb) { ST[kb].x = __expf(ST[kb].x - gm); ST[kb].y = __expf(ST[kb].y - gm); ST[kb].z = __expf(ST[kb].z - gm); ST[kb].w = __expf(ST[kb].w - gm); sum += (ST[kb].x + ST[kb].y) + (ST[kb].z + ST[kb].w);
            if (l15 < 8) *(LAS f32x4*)(Pl + l15 * 256 + wave * 32 + kb * 16 + 4 * lq) = ST[kb]; }
        sum += __shfl_xor(sum, 16); sum += __shfl_xor(sum, 32);
        if (lane < 8) reds[wave * 8 + lane] = sum;
        __syncthreads();
        f32x4 o[8];
#pragma unroll
        for (int q = 0; q < 8; ++q) o[q] = (f32x4){0.f, 0.f, 0.f, 0.f};
        const float* vp = CV + ((size_t)(b * NMEM + wave * 32)) * DM + h * 256 + 4 * lane;
#pragma unroll 4
        for (int k = 0; k < 32; ++k) { const f32x4 v = *(const GAS f32x4*)(vp + (size_t)k * DM);
#pragma unroll
            for (int q = 0; q < 8; ++q) { const float pq = Pl[q * 256 + wave * 32 + k]; o[q] = o[q] + v * pq; } }
#pragma unroll
        for (int q = 0; q < 8; ++q) *(LAS f32x4*)(Ored + (wave * 8 + q) * 256 + 4 * lane) = o[q];
        __syncthreads();
        { const int q = tid >> 6, d4 = (tid & 63) * 4; float tot = 0.f;
#pragma unroll
          for (int w = 0; w < 8; ++w) tot += reds[w * 8 + q];
          f32x4 s = (f32x4){0.f, 0.f, 0.f, 0.f};
#pragma unroll
          for (int w = 0; w < 8; ++w) s = s + *(const LAS f32x4*)(Ored + (w * 8 + q) * 256 + d4);
          const float inv = 1.0f / tot; v2u w2; w2.x = pk2(s.x * inv, s.y * inv); w2.y = pk2(s.z * inv, s.w * inv);
          *(GAS v2u*)(O + (size_t)(MP + b * LS + q) * DM + h * 256 + d4) = w2; }
        __syncthreads();
    }
}

constexpr int REP_GEMM = 1, REP_SCAN = 1, REP_ATT = 1, REP_MISC = 1, REP_PRO = 1;
__device__ __forceinline__ int opq(int v) { asm volatile("" : "+s"(v)); return v; }
typedef const __attribute__((address_space(4))) Args* ArgsP;
__device__ __forceinline__ Frame make_frame(LAS unsigned char* lds) {
    Frame F; int t = threadIdx.x; asm volatile("" : "+v"(t));
    F.lds = lds; F.tid = t; F.lane = t & 63; F.wave = __builtin_amdgcn_readfirstlane(t >> 6);
    F.G = gridDim.x; { const int bx = blockIdx.x; F.vcu = (F.G % 8 == 0) ? (bx % 8) * (F.G / 8) + bx / 8 : bx; }
    F.gw = F.vcu * NWAVES + F.wave; F.NGW = F.G * NWAVES; F.gt = F.vcu * NTHR + F.tid; F.NGT = F.G * NTHR;
    return F;
}
#define PH_BEGIN ArgsP A_ = ap0; asm volatile("" : "+s"(A_)); const Frame F = make_frame(ldsp); unsigned char* const ws = A_->ws; float* const OUT = A_->out; (void)OUT; (void)ws

__global__ void __launch_bounds__(NTHR, 2) mega_fwd(Args args) {
    extern __shared__ __attribute__((aligned(16))) unsigned char lds[];
    LAS unsigned char* const ldsp = (LAS unsigned char*)lds;
    const ArgsP ap0 = (ArgsP)__builtin_amdgcn_kernarg_segment_ptr();
    XcdBarrier bar;
    { volatile LAS unsigned* MISC = (volatile LAS unsigned*)(ldsp + MISC_OFF);
      for (int u = threadIdx.x; u < (LDS_BYTES - LDSCTL_OFF) / 4; u += NTHR) ((LAS unsigned*)(ldsp + LDSCTL_OFF))[u] = 0u;
      __syncthreads();
      bar = xcd_barrier_post((unsigned*)(args.ws + WS_CTL) + 4096, MISC + 8); }
#define GRID_BAR() xcd_barrier(bar)

    for (int rep = 0, nrep_ = opq(REP_PRO); rep < nrep_; ++rep) { PH_BEGIN; p0_prologue(F, A_); }
    GRID_BAR();

    for (int rep = 0, nrep_ = opq(REP_GEMM); rep < nrep_; ++rep) { PH_BEGIN; pg8::Gemm g{(const bf16*)(ws + WS_MEMN), (const bf16*)(ws + WS_WMEM), BP * NMEM, 8192, DM, DM, -1}; pg8::StaticOrder S; S.init(g.M, g.N, F.G, (int)blockIdx.x);
      pg8::EpiMemKV E{OUT + O_MKP, OUT + O_MVP, (bf16*)(ws + WS_KP)};
      pg8::gemm_phase<pg8::EpiMemKV, pg8::StaticOrder>(F.lds, g, S, E); }
    for (int rep = 0, nrep_ = opq(REP_GEMM); rep < nrep_; ++rep) { PH_BEGIN; pg8::Gemm g{(const bf16*)(ws + WS_WMEM) + (size_t)4096 * DM, (const bf16*)(ws + WS_MEMN), 4096, BP * NMEM, DM, DM, -1}; pg8::StaticOrder S; S.init(g.M, g.N, F.G, (int)blockIdx.x);
      pg8::EpiBf16 E{(bf16*)(ws + WS_VT), BP * NMEM};
      pg8::gemm_phase<pg8::EpiBf16, pg8::StaticOrder>(F.lds, g, S, E); }

    for (int layer = 0; layer < DEPTH; ++layer) {
        const int kind = layer % 3, idx = layer / 3;
        for (int rep = 0, nrep_ = opq(REP_GEMM); rep < nrep_; ++rep) { PH_BEGIN;
          const bf16* win = kind == 0 ? (const bf16*)(ws + WS_RGWIN) + (size_t)idx * 4096 * DM : kind == 1 ? (const bf16*)(ws + WS_SSDWIN) : (const bf16*)(ws + WS_HGWIN);
          const int nin = kind == 0 ? 4096 : kind == 1 ? SSD_NPAD : 8192;
          pg8::Gemm g{(const bf16*)(ws + WS_XN), win, MT, nin, DM, DM, -1}; pg8::StaticOrder S; S.init(MT, nin, F.G, (int)blockIdx.x);
          pg8::EpiBf16 E{(bf16*)(ws + WS_P), nin};
          pg8::gemm_phase<pg8::EpiBf16, pg8::StaticOrder>(F.lds, g, S, E); }
        GRID_BAR();
        if (kind == 0) {
            for (int rep = 0, nrep_ = opq(REP_SCAN); rep < nrep_; ++rep) { PH_BEGIN;
              RgF rp{(const bf16*)(ws + WS_P), (const bf16*)(ws + WS_RGWAX) + (size_t)idx * 4096 * 256, A_->in[I_RG_CW] + (size_t)idx * 4 * BR, A_->in[I_RG_CB] + (size_t)idx * BR,
                     A_->in[I_RG_BA] + (size_t)idx * BR, A_->in[I_RG_BX] + (size_t)idx * BR, A_->in[I_RG_LAM] + (size_t)idx * BR,
                     A_->in[I_ST_RGC] + (size_t)idx * BS * 3 * BR, A_->in[I_ST_RGH] + (size_t)idx * BS * BR, (bf16*)(ws + WS_HGB),
                     OUT + O_RGCP + (size_t)idx * BP * 3 * BR, OUT + O_RGCS + (size_t)idx * BS * 3 * BR, OUT + O_RGHP + (size_t)idx * BP * BR, OUT + O_RGHS + (size_t)idx * BS * BR};
              rg_fused(F, rp, (gu32*)(ws + WS_CTL) + 8192 + 64 * (2 + idx) + 256 * rep); }
        } else if (kind == 1) {
            for (int rep = 0, nrep_ = opq(REP_MISC); rep < nrep_; ++rep) { PH_BEGIN;
              conv_phase<true>(F, (const bf16*)(ws + WS_P), SSD_NPAD, 2048, SSD_CONV, A_->in[I_ST_SC], A_->in[I_SSD_CW], A_->in[I_SSD_CB], (bf16*)(ws + WS_T1), OUT + O_SCP, OUT + O_SCS);
              ssd_dt_phase(F, (const bf16*)(ws + WS_P), A_->in[I_SSD_DTB], (float*)(ws + WS_DT)); }
            GRID_BAR();
            for (int rep = 0, nrep_ = opq(REP_SCAN); rep < nrep_; ++rep) { PH_BEGIN; ssd_prompt(F, (const bf16*)(ws + WS_T1), (const float*)(ws + WS_DT), A_->in[I_SSD_ALOG], (float*)(ws + WS_T2), (float*)(ws + WS_T3), OUT + O_SSP);
              ssd_scan(F, (const bf16*)(ws + WS_T1), (const float*)(ws + WS_DT), A_->in[I_SSD_ALOG], A_->in[I_ST_SS], (float*)(ws + WS_T2), OUT + O_SSS, (gu32*)(ws + WS_CTL) + 8192 + 64 * 1); }
            GRID_BAR();
            for (int rep = 0, nrep_ = opq(REP_MISC); rep < nrep_; ++rep) { PH_BEGIN; ssd_norm(F, (const float*)(ws + WS_T2), (const float*)(ws + WS_T3), (const bf16*)(ws + WS_T1), (const bf16*)(ws + WS_P), A_->in[I_SSD_D], (bf16*)(ws + WS_HGB)); }
        } else {
            for (int rep = 0, nrep_ = opq(REP_SCAN); rep < nrep_; ++rep) { PH_BEGIN; hgrn_prompt(F, (const bf16*)(ws + WS_P), (const float*)(ws + WS_LB) + (size_t)layer * BR, (float*)(ws + WS_T2), OUT + O_HSP);
              hgrn_scan(F, (const bf16*)(ws + WS_P), (const float*)(ws + WS_LB) + (size_t)layer * BR, A_->in[I_ST_HG], (float*)(ws + WS_T2), OUT + O_HSS, (gu32*)(ws + WS_CTL) + 8192 + 64 * 0); }
            GRID_BAR();
            for (int rep = 0, nrep_ = opq(REP_MISC); rep < nrep_; ++rep) { PH_BEGIN; hgrn_norm(F, (const float*)(ws + WS_T2), (const bf16*)(ws + WS_P), (bf16*)(ws + WS_HGB)); }
        }
        GRID_BAR();
        for (int rep = 0, nrep_ = opq(REP_GEMM); rep < nrep_; ++rep) { PH_BEGIN;
          const bf16* wout = kind == 0 ? (const bf16*)(ws + WS_RGWOUT) + (size_t)idx * DM * BR : kind == 1 ? (const bf16*)(ws + WS_SSDWOUT) : (const bf16*)(ws + WS_HGWOUT);
          pg8::Gemm g{(const bf16*)(ws + WS_HGB), wout, MT, DM, BR, BR, -1}; pg8::StaticOrder S; S.init(MT, DM, F.G, (int)blockIdx.x);
          pg8::EpiF32 E{(float*)(ws + WS_Y), DM};
          pg8::gemm_phase<pg8::EpiF32, pg8::StaticOrder>(F.lds, g, S, E); }
        GRID_BAR();
        { PH_BEGIN; thin_pass(F, (const float*)(ws + WS_Y), OUT, (bf16*)(ws + WS_XN), A_->in[I_NG] + (size_t)(layer * 4 + 1) * DM, true); }
        GRID_BAR();
        for (int rep = 0, nrep_ = opq(REP_GEMM); rep < nrep_; ++rep) { PH_BEGIN; pg8::Gemm g{(const bf16*)(ws + WS_XN), (const bf16*)(ws + WS_XWQ) + (size_t)layer * DM * DM, MT, DM, DM, DM, -1}; pg8::StaticOrder S; S.init(MT, DM, F.G, (int)blockIdx.x);
          pg8::EpiBf16 E{(bf16*)(ws + WS_Q), DM};
          pg8::gemm_phase<pg8::EpiBf16, pg8::StaticOrder>(F.lds, g, S, E); }
        GRID_BAR();
        for (int rep = 0, nrep_ = opq(REP_ATT); rep < nrep_; ++rep) { PH_BEGIN; attn_prompt(F, (const bf16*)(ws + WS_Q), (const bf16*)(ws + WS_KP) + (size_t)layer * 2048 * DM, (const bf16*)(ws + WS_VT) + (size_t)layer * 1024 * 2048, (bf16*)(ws + WS_OA)); }
        for (int rep = 0, nrep_ = opq(REP_ATT); rep < nrep_; ++rep) { PH_BEGIN; attn_sample(F, (const bf16*)(ws + WS_Q), A_->in[I_CK] + (size_t)layer * BS * NMEM * DM, A_->in[I_CV] + (size_t)layer * BS * NMEM * DM, (bf16*)(ws + WS_OA)); }
        GRID_BAR();
        for (int rep = 0, nrep_ = opq(REP_GEMM); rep < nrep_; ++rep) { PH_BEGIN; pg8::Gemm g{(const bf16*)(ws + WS_OA), (const bf16*)(ws + WS_XWO) + (size_t)layer * DM * DM, MT, DM, DM, DM, -1}; pg8::StaticOrder S; S.init(MT, DM, F.G, (int)blockIdx.x);
          pg8::EpiF32 E{(float*)(ws + WS_Y), DM};
          pg8::gemm_phase<pg8::EpiF32, pg8::StaticOrder>(F.lds, g, S, E); }
        GRID_BAR();
        { PH_BEGIN; thin_pass(F, (const float*)(ws + WS_Y), OUT, (bf16*)(ws + WS_XN), A_->in[I_NG] + (size_t)(layer * 4 + 3) * DM, layer + 1 < DEPTH); }
        if (layer + 1 < DEPTH) GRID_BAR();
    }
}

extern "C" void kernel_launch(void* const* d_in, const int* in_sizes, int n_in, void* d_out, int out_size, void* d_ws, size_t ws_size, hipStream_t stream) {
    static int grid = 0;
    if (grid == 0) {
        if (n_in != N_IN || (size_t)out_size != O_END || ws_size < WS_END) { fprintf(stderr, "kernel_launch: unexpected sizes: n_in %d out %d ws %zu\n", n_in, out_size, ws_size); grid = -1; return; }
        int dev = 0, cus = 0, per_cu = 0;
        if (hipGetDevice(&dev) != hipSuccess || hipDeviceGetAttribute(&cus, hipDeviceAttributeMultiprocessorCount, dev) != hipSuccess) { grid = -1; return; }
        if (hipFuncSetAttribute((const void*)mega_fwd, hipFuncAttributeMaxDynamicSharedMemorySize, LDS_BYTES) != hipSuccess) { fprintf(stderr, "kernel_launch: hipFuncSetAttribute failed\n"); grid = -1; return; }
        if (hipOccupancyMaxActiveBlocksPerMultiprocessor(&per_cu, (const void*)mega_fwd, NTHR, LDS_BYTES) != hipSuccess || per_cu < 1) fprintf(stderr, "kernel_launch: occupancy query reports %d\n", per_cu);
        (void)hipGetLastError();
        grid = cus;
    }
    if (grid < 0) return;
    (void)hipMemsetAsync((char*)d_ws + WS_CTL, 0, CTL_ZERO_BYTES, stream);
    Args a{};
    for (int i = 0; i < N_IN; ++i) a.in[i] = (const float*)d_in[i];
    a.out = (float*)d_out; a.ws = (unsigned char*)d_ws;
    unsigned char* ws = (unsigned char*)d_ws;
    int nd = 0, items = 0;
    auto add = [&](const float* src, const float* gain, size_t dst_off, int K, int N, float scale) {
        WDesc& d = a.wd[nd++]; d.src = src; d.gain = gain; d.dst = (bf16*)(ws + dst_off); d.K = K; d.N = N; d.scale = scale; d.item0 = items; items += (K / 64) * (N / 32); };
    const float* NG = a.in[I_NG];
    for (int l = 0; l < DEPTH; ++l) {
        add(a.in[I_XWK] + (size_t)l * DM * DM, a.in[I_MNG] + (size_t)l * DM, WS_WMEM + ((size_t)l * 1024) * DM * 2, DM, DM, 1.f);
        add(a.in[I_XWV] + (size_t)l * DM * DM, a.in[I_MNG] + (size_t)l * DM, WS_WMEM + ((size_t)4096 + (size_t)l * 1024) * DM * 2, DM, DM, 1.f);
    }
    for (int i = 0; i < 2; ++i) {
        const int layer = 3 * i;
        add(a.in[I_RG_WIN] + (size_t)i * DM * 4096, NG + (size_t)(layer * 4 + 0) * DM, WS_RGWIN + (size_t)i * 4096 * DM * 2, DM, 4096, 1.f);
        for (int j = 0; j < 8; ++j) {
            add(a.in[I_RG_WA] + ((size_t)i * 8 + j) * 256 * 256, nullptr, WS_RGWAX + ((size_t)i * 4096 + (size_t)j * 512) * 256 * 2, 256, 256, 1.f);
            add(a.in[I_RG_WX] + ((size_t)i * 8 + j) * 256 * 256, nullptr, WS_RGWAX + ((size_t)i * 4096 + (size_t)j * 512 + 256) * 256 * 2, 256, 256, 1.f);
        }
        add(a.in[I_RG_WOUT] + (size_t)i * BR * DM, nullptr, WS_RGWOUT + (size_t)i * DM * BR * 2, BR, DM, 1.f);
    }
    add(a.in[I_SSD_WIN], NG + (size_t)(1 * 4 + 0) * DM, WS_SSDWIN, DM, SSD_NIN, 1.f);
    add(a.in[I_SSD_WOUT], a.in[I_SSD_NG], WS_SSDWOUT, BR, DM, 1.f);
    add(a.in[I_HG_WIN], NG + (size_t)(2 * 4 + 0) * DM, WS_HGWIN, DM, 8192, 1.f);
    add(a.in[I_HG_WOUT], a.in[I_HG_NG], WS_HGWOUT, BR, DM, 1.f);
    for (int l = 0; l < DEPTH; ++l) {
        add(a.in[I_XWQ] + (size_t)l * DM * DM, NG + (size_t)(l * 4 + 2) * DM, WS_XWQ + (size_t)l * DM * DM * 2, DM, DM, 0.0625f);
        add(a.in[I_XWO] + (size_t)l * DM * DM, nullptr, WS_XWO + (size_t)l * DM * DM * 2, DM, DM, 1.f);
    }
    if (nd != NWD) { fprintf(stderr, "kernel_launch: descriptor count %d != %d\n", nd, NWD); return; }
    a.nitems = items; a.pad = 0;
    hipLaunchKernelGGL(mega_fwd, dim3(grid), dim3(NTHR), LDS_BYTES, stream, a);
    const hipError_t le = hipPeekAtLastError();
    if (le != hipSuccess) fprintf(stderr, "kernel_launch: launch failed: %s\n", hipGetErrorName(le));
}
```

```cpp
#include <hip/hip_runtime.h>
#include <cstdio>
#include <cstdint>

namespace pg8 {
#define PG8_LAS __attribute__((address_space(3)))
typedef unsigned short bf16_t;
typedef short bf16x8 __attribute__((ext_vector_type(8)));
typedef float f32x4 __attribute__((ext_vector_type(4)));
typedef unsigned u32x4 __attribute__((ext_vector_type(4)));
typedef unsigned u32x2 __attribute__((ext_vector_type(2)));
constexpr int BM = 256, BK = 64, HALF = 128, HTB = HALF * BK * 2, STAGE_BYTES = 8 * HTB, NXCD = 8, WGM = 8;

__host__ __device__ __forceinline__ int lds_byte(int r, int c) { const int st = (r >> 4) * 2 + (c >> 5), rr = r & 15, cc = c & 31, ob = rr * 64 + cc * 2; return st * 1024 + (ob ^ (((ob >> 9) & 1) << 5)); }
__host__ __device__ __forceinline__ void stage_rc(int b, int& R, int& C) { const int st = b / 1024, sb = b % 1024, swz = sb ^ (((sb >> 9) & 1) << 5); R = (st >> 1) * 16 + swz / 64; C = (st & 1) * 32 + (swz % 64) / 2; }
__host__ __device__ __forceinline__ int perm32(int rho) { const int n = rho >> 4, i = rho & 15; return 8 * (i >> 2) + 4 * n + (i & 3); }

struct Unit { int pm, pn; };
struct Gemm { const bf16_t* A; const bf16_t* Bt; int M, N, K, lda, a_shift; };

struct StaticOrder {
    int nM, nN, nwg, G, c;
    __host__ __device__ void init(int M, int N, int G_, int c_) { nM = M / BM; nN = N / BM; nwg = nM * nN; G = G_; c = c_; }
    __host__ __device__ bool next(int i, Unit& u) const {
        const long L = (long)i * G + c; if (L >= nwg) return false;
        int wgid = (int)L; { const int q = nwg / NXCD, r = nwg % NXCD, xcd = wgid % NXCD, off = wgid / NXCD; wgid = (xcd < r ? xcd * (q + 1) : r * (q + 1) + (xcd - r) * q) + off; }
        const int nig = WGM * nN, gid = wgid / nig, fm = gid * WGM, gsz = (nM - fm) < WGM ? (nM - fm) : WGM;
        u.pm = fm + ((wgid % nig) % gsz); u.pn = (wgid % nig) / gsz; return true;
    }
    __device__ __forceinline__ void a_ready(const Unit&) const {}
    __device__ __forceinline__ void done(const Unit&) const {}
};

__device__ __forceinline__ unsigned cvt_pk_bf16(float lo, float hi) { unsigned r; asm volatile("v_cvt_pk_bf16_f32 %0, %1, %2" : "=v"(r) : "v"(lo), "v"(hi)); return r; }

struct EpiF32 {
    static constexpr bool PERM = false, AFTER_DRAIN = false;
    float* C; int ldc;
    __device__ __forceinline__ void operator()(const f32x4 (&acc)[2][2][4][2], const Unit& u, int wr, int wc, int fr, int fq) const {
        const int row0 = u.pm * BM + wr * 64 + fr, col0 = u.pn * BM + wc * 32 + 4 * fq;
#pragma unroll
        for (int ai = 0; ai < 2; ++ai)
#pragma unroll
            for (int m = 0; m < 4; ++m) { float* rowp = C + (size_t)(row0 + ai * HALF + m * 16) * ldc + col0;
#pragma unroll
                for (int bj = 0; bj < 2; ++bj)
#pragma unroll
                    for (int n = 0; n < 2; ++n) *(f32x4*)(rowp + bj * HALF + n * 16) = acc[ai][bj][m][n]; }
    }
};
struct EpiBf16 {
    static constexpr bool PERM = true, AFTER_DRAIN = false;
    bf16_t* O; int ldc;
    __device__ __forceinline__ void operator()(const f32x4 (&acc)[2][2][4][2], const Unit& u, int wr, int wc, int fr, int fq) const {
        const int row0 = u.pm * BM + wr * 64 + fr, col0 = u.pn * BM + wc * 32 + 8 * fq;
#pragma unroll
        for (int ai = 0; ai < 2; ++ai)
#pragma unroll
            for (int m = 0; m < 4; ++m) { bf16_t* rowp = O + (size_t)(row0 + ai * HALF + m * 16) * ldc + col0;
#pragma unroll
                for (int bj = 0; bj < 2; ++bj) { const f32x4 v0 = acc[ai][bj][m][0], v1 = acc[ai][bj][m][1];
                    u32x4 w; w.x = cvt_pk_bf16(v0[0], v0[1]); w.y = cvt_pk_bf16(v0[2], v0[3]); w.z = cvt_pk_bf16(v1[0], v1[1]); w.w = cvt_pk_bf16(v1[2], v1[3]);
                    *(u32x4*)(rowp + bj * HALF) = w; } }
    }
};
struct EpiMemKV {
    static constexpr bool PERM = false, AFTER_DRAIN = false;
    float* outK; float* outV; bf16_t* KP;
    __device__ __forceinline__ void operator()(const f32x4 (&acc)[2][2][4][2], const Unit& u, int wr, int wc, int fr, int fq) const {
        const int kv = u.pn >> 4, layer = (u.pn >> 2) & 3, ct = u.pn & 3;
        const int row0 = u.pm * BM + wr * 64 + fr, col0 = ct * BM + wc * 32 + 4 * fq;
        float* C = (kv ? outV : outK) + (size_t)layer * 2048 * 1024;
        bf16_t* Kb = KP + (size_t)layer * 2048 * 1024;
#pragma unroll
        for (int ai = 0; ai < 2; ++ai)
#pragma unroll
            for (int m = 0; m < 4; ++m) { const size_t off = (size_t)(row0 + ai * HALF + m * 16) * 1024 + col0;
#pragma unroll
                for (int bj = 0; bj < 2; ++bj)
#pragma unroll
                    for (int n = 0; n < 2; ++n) { const f32x4 v = acc[ai][bj][m][n]; *(f32x4*)(C + off + bj * HALF + n * 16) = v;
                        if (kv == 0) { u32x2 w; w.x = cvt_pk_bf16(v[0], v[1]); w.y = cvt_pk_bf16(v[2], v[3]); *(u32x2*)(Kb + off + bj * HALF + n * 16) = w; } } }
    }
};

template <class Epi, class Sched>
__device__ __forceinline__ void gemm_phase(PG8_LAS unsigned char* lds, const Gemm g, const Sched& S, const Epi& E) {
    int tid_ = threadIdx.x; asm volatile("" : "+v"(tid_));
    const int tid = tid_, wid = __builtin_amdgcn_readfirstlane(tid >> 6), lane = tid & 63, wr = wid >> 2, wc = wid & 3, fr = lane & 15, fq = lane >> 4;
    const int K = g.K, nt = K / BK, lda = g.lda;
    unsigned voffA[2], voffB[2];
#pragma unroll
    for (int i = 0; i < 2; ++i) { int R, C; stage_rc(tid * 16 + i * 8192, R, C); const int Rb = Epi::PERM ? ((R & ~31) + perm32(R & 31)) : R;
        voffA[i] = (unsigned)(R * lda + C) * 2u; voffB[i] = (unsigned)(Rb * K + C) * 2u; }
    const size_t kstep = (size_t)(BK * 2);
    const size_t hsA = (size_t)HALF * lda * 2, tsA = 2 * hsA;
    const size_t hsB = (size_t)HALF * K * 2, tsB = 2 * hsB;
    const unsigned ldsw = (unsigned)wid * 1024u;
    const int aoff = lds_byte(wr * 64 + fr, fq * 8), boff = lds_byte(wc * 32 + fr, fq * 8);
#define PG8_SA(b, h) (((b) * 2 + (h)) * HTB)
#define PG8_SB(b, h) ((4 + (b) * 2 + (h)) * HTB)
#define PG8_STAGE(bufoff, gbase, voff) do { _Pragma("unroll") for (int _i = 0; _i < 2; ++_i) \
        __builtin_amdgcn_global_load_lds((const unsigned*)((const char*)(gbase) + (voff)[_i]), (PG8_LAS unsigned*)(lds + (bufoff) + ldsw + _i * 8192), 16, 0, 0); } while (0)
#define PG8_LDA(dst, b, h) do { _Pragma("unroll") for (int m = 0; m < 4; ++m) _Pragma("unroll") for (int k = 0; k < 2; ++k) dst[m][k] = *(const PG8_LAS bf16x8*)(lds + PG8_SA(b, h) + aoff + m * 2048 + k * 1024); } while (0)
#define PG8_LDB(dst, b, h) do { _Pragma("unroll") for (int n = 0; n < 2; ++n) _Pragma("unroll") for (int k = 0; k < 2; ++k) dst[n][k] = *(const PG8_LAS bf16x8*)(lds + PG8_SB(b, h) + boff + n * 2048 + k * 1024); } while (0)
#define PG8_MMA(ai, bj, At, Bt) do { __builtin_amdgcn_s_setprio(1); _Pragma("unroll") for (int m = 0; m < 4; ++m) _Pragma("unroll") for (int n = 0; n < 2; ++n) _Pragma("unroll") for (int k = 0; k < 2; ++k) \
        acc[ai][bj][m][n] = __builtin_amdgcn_mfma_f32_16x16x32_bf16(Bt[n][k], At[m][k], acc[ai][bj][m][n], 0, 0, 0); __builtin_amdgcn_s_setprio(0); } while (0)
#define PG8_WAIT_V(n) asm volatile("s_waitcnt vmcnt(" #n ")" ::: "memory")
#define PG8_WAIT_L(n) asm volatile("s_waitcnt lgkmcnt(" #n ")" ::: "memory")
#define PG8_BAR __builtin_amdgcn_s_barrier()
#define PG8_SCHED __builtin_amdgcn_sched_barrier(0)
#define PG8_ABASE(u) ((const char*)g.A + (size_t)(u).pm * tsA + (g.a_shift >= 0 ? (size_t)((u).pn >> g.a_shift) * 512 : (size_t)0))
    Unit cur, nxt; int ui = 0;
    if (!S.next(0, cur)) return;
    f32x4 acc[2][2][4][2];
#pragma unroll
    for (int a = 0; a < 2; ++a)
#pragma unroll
        for (int b = 0; b < 2; ++b)
#pragma unroll
            for (int m = 0; m < 4; ++m)
#pragma unroll
                for (int n = 0; n < 2; ++n) acc[a][b][m][n] = (f32x4){0.f, 0.f, 0.f, 0.f};
    bf16x8 At[4][2], B0[2][2], B1[2][2];
    const char* cA = PG8_ABASE(cur); const char* cB = (const char*)g.Bt + (size_t)cur.pn * tsB;
    S.a_ready(cur);
    PG8_STAGE(PG8_SB(0, 0), cB, voffB); PG8_STAGE(PG8_SA(0, 0), cA, voffA); PG8_STAGE(PG8_SB(0, 1), cB + hsB, voffB); PG8_STAGE(PG8_SA(0, 1), cA + hsA, voffA);
    if (wr == 1) PG8_BAR;
    PG8_WAIT_V(4); PG8_BAR;
    PG8_STAGE(PG8_SB(1, 0), cB + kstep, voffB); PG8_STAGE(PG8_SA(1, 0), cA + kstep, voffA); PG8_STAGE(PG8_SB(1, 1), cB + hsB + kstep, voffB);
    PG8_WAIT_V(6); PG8_BAR;
    for (;;) {
        const bool has_next = S.next(ui + 1, nxt);
        const char* nA = has_next ? PG8_ABASE(nxt) : cA; const char* nB = has_next ? (const char*)g.Bt + (size_t)nxt.pn * tsB : cB;
        for (int t = 0; t < nt; t += 2) {
            const bool last = (t == nt - 2);
            const char* a1 = cA + (size_t)(t + 1) * kstep;
            const char* a2 = last ? nA : cA + (size_t)(t + 2) * kstep; const char* b2 = last ? nB : cB + (size_t)(t + 2) * kstep;
            const char* a3 = a2 + kstep; const char* b3 = b2 + kstep;
            if (last && has_next) S.a_ready(nxt);
            PG8_LDB(B0, 0, 0); PG8_SCHED; PG8_LDA(At, 0, 0); PG8_STAGE(PG8_SA(1, 1), a1 + hsA, voffA);
            PG8_WAIT_L(8); PG8_BAR; PG8_WAIT_L(0); PG8_MMA(0, 0, At, B0); PG8_BAR; PG8_SCHED;
            PG8_LDB(B1, 0, 1); PG8_STAGE(PG8_SB(0, 0), b2, voffB);
            PG8_BAR; PG8_WAIT_L(0); PG8_MMA(0, 1, At, B1); PG8_BAR;
            PG8_LDA(At, 0, 1); PG8_STAGE(PG8_SA(0, 0), a2, voffA);
            PG8_BAR; PG8_WAIT_L(0); PG8_MMA(1, 0, At, B0); PG8_BAR; PG8_SCHED;
            PG8_STAGE(PG8_SB(0, 1), b2 + hsB, voffB);
            PG8_WAIT_V(6); PG8_BAR; PG8_MMA(1, 1, At, B1); PG8_BAR;
            PG8_LDB(B0, 1, 0); PG8_SCHED; PG8_LDA(At, 1, 0); PG8_STAGE(PG8_SA(0, 1), a2 + hsA, voffA);
            PG8_WAIT_L(8); PG8_BAR; PG8_WAIT_L(0); PG8_MMA(0, 0, At, B0); PG8_BAR; PG8_SCHED;
            PG8_LDB(B1, 1, 1); PG8_STAGE(PG8_SB(1, 0), b3, voffB);
            PG8_BAR; PG8_WAIT_L(0); PG8_MMA(0, 1, At, B1); PG8_BAR;
            PG8_LDA(At, 1, 1); PG8_STAGE(PG8_SA(1, 0), a3, voffA);
            PG8_BAR; PG8_WAIT_L(0); PG8_MMA(1, 0, At, B0); PG8_BAR; PG8_SCHED;
            PG8_STAGE(PG8_SB(1, 1), b3 + hsB, voffB);
            PG8_WAIT_V(6); PG8_BAR; PG8_MMA(1, 1, At, B1); PG8_BAR;
        }
        if constexpr (!Epi::AFTER_DRAIN) { E(acc, cur, wr, wc, fr, fq); S.done(cur); }
        if (!has_next) break;
#pragma unroll
        for (int a = 0; a < 2; ++a)
#pragma unroll
            for (int b = 0; b < 2; ++b)
#pragma unroll
                for (int m = 0; m < 4; ++m)
#pragma unroll
                    for (int n = 0; n < 2; ++n) acc[a][b][m][n] = (f32x4){0.f, 0.f, 0.f, 0.f};
        cur = nxt; cA = nA; cB = nB; ++ui;
    }
    PG8_WAIT_V(0);
    if (wr == 0) PG8_BAR;
    PG8_BAR;
#undef PG8_ABASE
#undef PG8_SA
#undef PG8_SB
#undef PG8_STAGE
#undef PG8_LDA
#undef PG8_LDB
#undef PG8_MMA
#undef PG8_WAIT_V
#undef PG8_WAIT_L
#undef PG8_BAR
#undef PG8_SCHED
}
}

constexpr int NWAVES = 8, NTHR = 512;
constexpr int DM = 1024, BP = 8, LP = 2048, BS = 128, LS = 8, NMEM = 256, DEPTH = 4;
constexpr int MP = BP * LP, MS = BS * LS, MT = MP + MS;
constexpr int BR = 2048;
constexpr int SSD_CONV = 4096, SSD_NIN = 6176, SSD_NPAD = 6400, SSD_H = 32, SSD_P = 64, SSD_N = 128;
constexpr int HG_H = 16, HG_DK = 128, HG_DV = 128;
constexpr float EPS = 1e-6f;

constexpr size_t O_YP = 0;
constexpr size_t O_YS = O_YP + (size_t)MP * DM;
constexpr size_t O_RGCP = O_YS + (size_t)MS * DM;
constexpr size_t O_RGHP = O_RGCP + (size_t)2 * BP * 3 * BR;
constexpr size_t O_SCP = O_RGHP + (size_t)2 * BP * BR;
constexpr size_t O_SSP = O_SCP + (size_t)BP * 3 * SSD_CONV;
constexpr size_t O_HSP = O_SSP + (size_t)BP * SSD_H * SSD_P * SSD_N;
constexpr size_t O_MKP = O_HSP + (size_t)BP * HG_H * HG_DK * HG_DV;
constexpr size_t O_MVP = O_MKP + (size_t)DEPTH * BP * NMEM * DM;
constexpr size_t O_RGCS = O_MVP + (size_t)DEPTH * BP * NMEM * DM;
constexpr size_t O_RGHS = O_RGCS + (size_t)2 * BS * 3 * BR;
constexpr size_t O_SCS = O_RGHS + (size_t)2 * BS * BR;
constexpr size_t O_SSS = O_SCS + (size_t)BS * 3 * SSD_CONV;
constexpr size_t O_HSS = O_SSS + (size_t)BS * SSD_H * SSD_P * SSD_N;
constexpr size_t O_END = O_HSS + (size_t)BS * HG_H * HG_DK * HG_DV;
static_assert(O_END == 109805568ull, "output size");

enum { I_XP = 0, I_XS, I_MEM, I_ST_RGC, I_ST_RGH, I_ST_SC, I_ST_SS, I_ST_HG, I_CK, I_CV, I_NG, I_MNG, I_RG_WIN, I_RG_CW, I_RG_CB, I_RG_WA, I_RG_BA, I_RG_WX, I_RG_BX,
       I_RG_LAM, I_RG_WOUT, I_SSD_WIN, I_SSD_CW, I_SSD_CB, I_SSD_DTB, I_SSD_ALOG, I_SSD_D, I_SSD_NG, I_SSD_WOUT, I_HG_WIN, I_HG_LB, I_HG_NG, I_HG_WOUT, I_XWQ, I_XWK, I_XWV, I_XWO, N_IN };

constexpr size_t MiB = 1u << 20;
constexpr size_t WS_CTL = 0, CTL_ZERO_BYTES = 1 * MiB;
constexpr size_t WS_LB = 1 * MiB;
constexpr size_t WS_CA = 2 * MiB, WS_CB = 4 * MiB;
constexpr size_t WS_WMEM = 8 * MiB;
constexpr size_t WS_RGWIN = WS_WMEM + 16 * MiB;
constexpr size_t WS_RGWAX = WS_RGWIN + 16 * MiB;
constexpr size_t WS_RGWOUT = WS_RGWAX + 4 * MiB;
constexpr size_t WS_SSDWIN = WS_RGWOUT + 8 * MiB;
constexpr size_t WS_SSDWOUT = WS_SSDWIN + 13 * MiB;
constexpr size_t WS_HGWIN = WS_SSDWOUT + 4 * MiB;
constexpr size_t WS_HGWOUT = WS_HGWIN + 16 * MiB;
constexpr size_t WS_XWQ = WS_HGWOUT + 4 * MiB;
constexpr size_t WS_XWO = WS_XWQ + 8 * MiB;
constexpr size_t WS_XN = 128 * MiB;
constexpr size_t WS_P = WS_XN + 36 * MiB;
constexpr size_t WS_HGB = WS_P + 288 * MiB;
constexpr size_t WS_Y = WS_HGB + 72 * MiB;
constexpr size_t WS_Q = WS_Y + 72 * MiB;
constexpr size_t WS_OA = WS_Q + 36 * MiB;
constexpr size_t WS_MEMN = WS_OA + 36 * MiB;
constexpr size_t WS_KP = WS_MEMN + 4 * MiB;
constexpr size_t WS_VT = WS_KP + 16 * MiB;
constexpr size_t WS_T1 = WS_VT + 16 * MiB;
constexpr size_t WS_T2 = WS_T1 + 144 * MiB;
constexpr size_t WS_DT = WS_T2 + 144 * MiB;
constexpr size_t WS_T3 = WS_DT + 4 * MiB;
constexpr size_t WS_END = WS_T3 + 144 * MiB;
static_assert(WS_XWO + 8 * MiB <= WS_XN, "weights region");

constexpr int RING_BYTES = 131072;
constexpr int LDS_BYTES = 147456;
constexpr int LDSCTL_OFF = LDS_BYTES - 1024, MISC_OFF = LDSCTL_OFF + 320;

#define GAS __attribute__((address_space(1)))
#define LAS __attribute__((address_space(3)))
typedef unsigned short bf16;
typedef unsigned v4u __attribute__((ext_vector_type(4)));
typedef unsigned v2u __attribute__((ext_vector_type(2)));
typedef float f32x4 __attribute__((ext_vector_type(4)));
typedef short bf16x8 __attribute__((ext_vector_type(8)));
typedef GAS unsigned gu32;
#define RLX_AGENT __ATOMIC_RELAXED, __HIP_MEMORY_SCOPE_AGENT
#define LDS_WAIT() asm volatile("s_waitcnt lgkmcnt(0)" ::: "memory")
#define VM_WAIT() asm volatile("s_waitcnt vmcnt(0)" ::: "memory")

__device__ __forceinline__ unsigned f2bf(float f) { unsigned u = __builtin_bit_cast(unsigned, f); return (u + 0x7fffu + ((u >> 16) & 1u)) >> 16; }
__device__ __forceinline__ unsigned pk2(float lo, float hi) { return f2bf(lo) | (f2bf(hi) << 16); }
__device__ __forceinline__ float bflo(unsigned w) { return __builtin_bit_cast(float, w << 16); }
__device__ __forceinline__ float bfhi(unsigned w) { return __builtin_bit_cast(float, w & 0xffff0000u); }
__device__ __forceinline__ float bf2f(bf16 v) { return __builtin_bit_cast(float, (unsigned)v << 16); }
__device__ __forceinline__ void unpack8(const v4u w, float (&f)[8]) { f[0] = bflo(w.x); f[1] = bfhi(w.x); f[2] = bflo(w.y); f[3] = bfhi(w.y); f[4] = bflo(w.z); f[5] = bfhi(w.z); f[6] = bflo(w.w); f[7] = bfhi(w.w); }
__device__ __forceinline__ v4u pack8(const float (&f)[8]) { v4u w; w.x = pk2(f[0], f[1]); w.y = pk2(f[2], f[3]); w.z = pk2(f[4], f[5]); w.w = pk2(f[6], f[7]); return w; }
__device__ __forceinline__ float sigmoid_f(float x) { return 1.0f / (1.0f + __expf(-x)); }
__device__ __forceinline__ float silu_f(float x) { return x / (1.0f + __expf(-x)); }
__device__ __forceinline__ float softplus_f(float x) { return x > 20.f ? x : log1pf(expf(x)); }

#define XB_TMO      128
#define XB_XCNT(j)  (256  + 64 * (j))
#define XB_XSUB(j)  (1280 + 64 * (j))
#define XB_XGEN(j)  (2304 + 64 * (j))
#define XB_TOP      3328
#define XB_TOPGEN   3392
#define XCD_BAR_WORDS 3456
#define XB_SPIN_CAP (1u << 18)

__device__ __forceinline__ unsigned xb_ld(unsigned* p)              { return __hip_atomic_load(p, __ATOMIC_RELAXED, __HIP_MEMORY_SCOPE_AGENT); }
__device__ __forceinline__ unsigned xb_add(unsigned* p, unsigned v) { return __hip_atomic_fetch_add(p, v, __ATOMIC_RELAXED, __HIP_MEMORY_SCOPE_AGENT); }
__device__ __forceinline__ unsigned xb_xcc_id() { return (unsigned)__builtin_amdgcn_s_getreg((3 << 11) | 20) & 0xFu; }
#define XB_SPIN(cond, bar) do { unsigned _sp = 0; while (cond) { __builtin_amdgcn_s_sleep(1); \
    if ((++_sp & 255u) == 0u) { if (xb_ld(&(bar)[XB_TMO])) break; if (_sp > XB_SPIN_CAP) { atomicAdd(&(bar)[XB_TMO], 1u); break; } } } } while (0)

struct XcdBarrier { unsigned* bar; unsigned x; volatile LAS unsigned* st; };

__device__ __forceinline__ XcdBarrier xcd_barrier_post(unsigned* bar, volatile LAS unsigned* st) {
    XcdBarrier b; b.bar = bar; b.x = xb_xcc_id(); b.st = st;
    if (threadIdx.x == 0) (void)xb_add(&bar[XB_XCNT(b.x)], 1u);
    return b;
}
__device__ __forceinline__ void xcd_barrier_complete(unsigned* bar, unsigned x, unsigned& nloc, unsigned& nx) {
    const unsigned G = gridDim.x * gridDim.y * gridDim.z;
    unsigned sum, cnt, mine, sp = 0u;
    for (;;) {
        sum = 0u; cnt = 0u; mine = 0u;
#pragma unroll
        for (unsigned j = 0; j < 16; ++j) { const unsigned c = xb_ld(&bar[XB_XCNT(j)]); sum += c; cnt += (c > 0u) ? 1u : 0u; mine = (j == x) ? c : mine; }
        if (sum == G) break;
        __builtin_amdgcn_s_sleep(1);
        if ((++sp & 255u) == 0u) { if (xb_ld(&bar[XB_TMO])) break; if (sp > XB_SPIN_CAP) { atomicAdd(&bar[XB_TMO], 1u); break; } }
    }
    nloc = mine > 0u ? mine : 1u; nx = cnt > 0u ? cnt : 1u;
}
__device__ __forceinline__ void xcd_barrier(const XcdBarrier& b) {
    asm volatile("s_waitcnt vmcnt(0)" ::: "memory");
    __syncthreads();
    if (threadIdx.x == 0) {
        unsigned* bar = b.bar;
        __builtin_amdgcn_s_waitcnt(0);
        unsigned nloc = b.st[0], nx = b.st[1];
        if (nloc == 0u) { xcd_barrier_complete(bar, b.x, nloc, nx); b.st[0] = nloc; b.st[1] = nx; }
        const unsigned old = xb_add(&bar[XB_XSUB(b.x)], 1u);
        const unsigned gen = old / nloc;
        if (old + 1u == (gen + 1u) * nloc) {
            __builtin_amdgcn_fence(__ATOMIC_RELEASE, "agent");
            asm volatile("s_waitcnt vmcnt(0)" ::: "memory");
            const unsigned og = xb_add(&bar[XB_TOP], 1u);
            const unsigned tg = og / nx;
            if (og + 1u == (tg + 1u) * nx) xb_add(&bar[XB_TOPGEN], 1u);
            else XB_SPIN(xb_ld(&bar[XB_TOPGEN]) == tg, bar);
            __builtin_amdgcn_fence(__ATOMIC_ACQUIRE, "agent");
            xb_add(&bar[XB_XGEN(b.x)], 1u);
            asm volatile("s_waitcnt vmcnt(0)" ::: "memory");
        } else {
            XB_SPIN(xb_ld(&bar[XB_XGEN(b.x)]) == gen, bar);
            __builtin_amdgcn_fence(__ATOMIC_ACQUIRE, "agent");
            asm volatile("s_waitcnt vmcnt(0)" ::: "memory");
        }
    }
    __syncthreads();
}

struct WDesc { const float* src; const float* gain; bf16* dst; int K, N; float scale; int item0; };
constexpr int NWD = 56;
struct Args { const float* in[N_IN]; float* out; unsigned char* ws; WDesc wd[NWD]; int nitems; int pad; };

struct Frame {
    LAS unsigned char* lds;
    int tid, lane, wave;
    int vcu, G;
    int gw, NGW;
    int gt, NGT;
};

__device__ __forceinline__ float wave_sum(float v) {
#pragma unroll
    for (int o = 1; o < 64; o <<= 1) v += __shfl_xor(v, o);
    return v;
}

__device__ __forceinline__ void p0_transpose_item(const WDesc& d, LAS float* scr, int item, int lane) {
    const int K = d.K, N = d.N;
    const int nblk = N / 32, kb = item / nblk, nb = item % nblk, k0 = 64 * kb, n0 = 32 * nb;
    const float* W = d.src;
#pragma unroll 8
    for (int i = 0; i < 32; ++i) { const int kk = 2 * i + (lane >> 5); const float gsc = (d.gain ? d.gain[k0 + kk] : 1.0f) * d.scale;
        scr[kk * 33 + (lane & 31)] = W[(size_t)(k0 + kk) * N + n0 + (lane & 31)] * gsc; }
    LDS_WAIT(); asm volatile("" ::: "memory");
    const int c = lane & 7;
#pragma unroll
    for (int j = 0; j < 4; ++j) { const int n = (lane >> 3) + 8 * j; const LAS float* s = scr + (8 * c) * 33 + n;
        v4u o; o.x = pk2(s[0 * 33], s[1 * 33]); o.y = pk2(s[2 * 33], s[3 * 33]); o.z = pk2(s[4 * 33], s[5 * 33]); o.w = pk2(s[6 * 33], s[7 * 33]);
        *(GAS v4u*)(d.dst + (size_t)(n0 + n) * K + k0 + 8 * c) = o; }
    LDS_WAIT(); asm volatile("" ::: "memory");
}
__device__ __forceinline__ void rms_row_to_bf16(int lane, const float* xrow, bf16* orow, float* copy) {
    const GAS f32x4* xr = (const GAS f32x4*)xrow + lane;
    f32x4 v[4]; float s = 0.f;
#pragma unroll
    for (int j = 0; j < 4; ++j) { v[j] = xr[64 * j]; s += (v[j].x * v[j].x + v[j].y * v[j].y) + (v[j].z * v[j].z + v[j].w * v[j].w); }
    const float rstd = 1.0f / sqrtf(wave_sum(s) * (1.f / DM) + EPS);
    if (copy) { GAS f32x4* c4 = (GAS f32x4*)copy + lane;
#pragma unroll
        for (int j = 0; j < 4; ++j) c4[64 * j] = v[j]; }
    GAS v2u* o8 = (GAS v2u*)orow + lane;
#pragma unroll
    for (int j = 0; j < 4; ++j) { v2u w; w.x = pk2(v[j].x * rstd, v[j].y * rstd); w.y = pk2(v[j].z * rstd, v[j].w * rstd); o8[64 * j] = w; }
}

__device__ __forceinline__ void p0_prologue(const Frame& F, const __attribute__((address_space(4))) Args* ap) {
    const __attribute__((address_space(4))) Args& a = *ap;
    LAS float* scr = (LAS float*)(F.lds + F.wave * 16384);
    for (int it = F.gw; it < a.nitems; it += F.NGW) {
        int di = 0;
#pragma unroll 1
        for (int j = 1; j < NWD; ++j) if (it >= a.wd[j].item0) di = j;
        WDesc d; d.src = a.wd[di].src; d.gain = a.wd[di].gain; d.dst = a.wd[di].dst; d.K = a.wd[di].K; d.N = a.wd[di].N; d.scale = a.wd[di].scale; d.item0 = a.wd[di].item0;
        p0_transpose_item(d, scr, it - d.item0, F.lane);
    }
    { GAS v4u* z = (GAS v4u*)(a.ws + WS_SSDWIN + (size_t)SSD_NIN * DM * 2); const int nz = (SSD_NPAD - SSD_NIN) * DM * 2 / 16;
      for (int i = F.gt; i < nz; i += F.NGT) z[i] = (v4u){0u, 0u, 0u, 0u}; }
    { const float* lbp = a.in[I_HG_LB]; float* LB = (float*)(a.ws + WS_LB);
      for (int c = F.gt; c < BR; c += F.NGT) { const float v0 = lbp[c], v1 = lbp[BR + c], v2 = lbp[2 * BR + c], v3 = lbp[3 * BR + c];
          const float mx = fmaxf(fmaxf(v0, v1), fmaxf(v2, v3)); const float e0 = expf(v0 - mx), e1 = expf(v1 - mx), e2 = expf(v2 - mx), e3 = expf(v3 - mx); const float inv = 1.0f / (e0 + e1 + e2 + e3);
          LB[c] = 0.f; LB[BR + c] = e1 * inv; LB[2 * BR + c] = (e1 + e2) * inv; LB[3 * BR + c] = (e1 + e2 + e3) * inv; } }
    bf16* XN = (bf16*)(a.ws + WS_XN);
    for (int r = F.gw; r < MT; r += F.NGW) { const float* src = r < MP ? a.in[I_XP] + (size_t)r * DM : a.in[I_XS] + (size_t)(r - MP) * DM;
        rms_row_to_bf16(F.lane, src, XN + (size_t)r * DM, a.out + (size_t)r * DM); }
    bf16* MEMN = (bf16*)(a.ws + WS_MEMN);
    for (int r = F.gw; r < BP * NMEM; r += F.NGW) rms_row_to_bf16(F.lane, a.in[I_MEM] + (size_t)r * DM, MEMN + (size_t)r * DM, nullptr);
}

__device__ __forceinline__ void thin_pass(const Frame& F, const float* Y, float* X, bf16* XN, const float* g, bool write_xn) {
    f32x4 gv[4];
#pragma unroll
    for (int j = 0; j < 4; ++j) gv[j] = ((const GAS f32x4*)g)[64 * j + F.lane];
    for (int r = F.gw; r < MT; r += F.NGW) {
        const GAS f32x4* yr = (const GAS f32x4*)(Y + (size_t)r * DM) + F.lane;
        GAS f32x4* xr = (GAS f32x4*)(X + (size_t)r * DM) + F.lane;
        f32x4 y[4], x[4]; float s = 0.f;
#pragma unroll
        for (int j = 0; j < 4; ++j) { y[j] = yr[64 * j]; x[j] = xr[64 * j]; s += (y[j].x * y[j].x + y[j].y * y[j].y) + (y[j].z * y[j].z + y[j].w * y[j].w); }
        const float rstd = 1.0f / sqrtf(wave_sum(s) * (1.f / DM) + EPS);
        float s2 = 0.f;
#pragma unroll
        for (int j = 0; j < 4; ++j) { x[j] = x[j] + y[j] * rstd * gv[j]; s2 += (x[j].x * x[j].x + x[j].y * x[j].y) + (x[j].z * x[j].z + x[j].w * x[j].w); xr[64 * j] = x[j]; }
        if (write_xn) {
            const float rstd2 = 1.0f / sqrtf(wave_sum(s2) * (1.f / DM) + EPS);
            GAS v2u* o8 = (GAS v2u*)(XN + (size_t)r * DM) + F.lane;
#pragma unroll
            for (int j = 0; j < 4; ++j) { v2u w; w.x = pk2(x[j].x * rstd2, x[j].y * rstd2); w.y = pk2(x[j].z * rstd2, x[j].w * rstd2); o8[64 * j] = w; }
        }
    }
}

struct RowInfo { int sample, b, t, L; };
__device__ __forceinline__ RowInfo row_info(int r) { RowInfo i; if (r < MP) { i.sample = 0; i.b = r >> 11; i.t = r & 2047; i.L = LP; } else { const int rr = r - MP; i.sample = 1; i.b = rr >> 3; i.t = rr & 7; i.L = LS; } return i; }

template <bool SILU>
__device__ __forceinline__ void conv_phase(const Frame& F, const bf16* P, int ldp, int col0, int C, const float* state, const float* w, const float* bias, bf16* OUT, float* outp, float* outs) {
    const int cv = C / 8; const int total = MT * cv;
    for (int it = F.gt; it < total; it += F.NGT) {
        const int r = it / cv, c = (it - r * cv) * 8; const RowInfo ri = row_info(r);
        float u[4][8];
        unpack8(*(const GAS v4u*)(P + (size_t)r * ldp + col0 + c), u[0]);
#pragma unroll
        for (int k = 1; k < 4; ++k) {
            if (ri.t - k >= 0) unpack8(*(const GAS v4u*)(P + (size_t)(r - k) * ldp + col0 + c), u[k]);
            else if (ri.sample) { const float* sp = state + ((size_t)ri.b * 3 + (3 + ri.t - k)) * C + c; const f32x4 s0 = *(const GAS f32x4*)sp, s1 = *(const GAS f32x4*)(sp + 4);
                u[k][0] = s0.x; u[k][1] = s0.y; u[k][2] = s0.z; u[k][3] = s0.w; u[k][4] = s1.x; u[k][5] = s1.y; u[k][6] = s1.z; u[k][7] = s1.w; }
            else {
#pragma unroll
                for (int e = 0; e < 8; ++e) u[k][e] = 0.f; }
        }
        float o[8];
#pragma unroll
        for (int e = 0; e < 8; ++e) { float v = bias[c + e] + w[0 * C + c + e] * u[3][e] + w[1 * C + c + e] * u[2][e] + w[2 * C + c + e] * u[1][e] + w[3 * C + c + e] * u[0][e]; o[e] = SILU ? silu_f(v) : v; }
        *(GAS v4u*)(OUT + (size_t)r * C + c) = pack8(o);
        if (ri.t >= ri.L - 3) { float* dst = (ri.sample ? outs : outp) + ((size_t)ri.b * 3 + (ri.t - (ri.L - 3))) * C + c;
            *(GAS f32x4*)dst = (f32x4){u[0][0], u[0][1], u[0][2], u[0][3]}; *(GAS f32x4*)(dst + 4) = (f32x4){u[0][4], u[0][5], u[0][6], u[0][7]}; }
    }
}

struct RgPar { const bf16* UC; const bf16* RI; const bf16* P; const float* ba; const float* bx; const float* lam; };
__device__ __forceinline__ void rg_ab(const RgPar& p, int r, int c, const float (&sp)[4], const float (&ba)[4], const float (&bx)[4], float (&a)[4], float (&bb)[4]) {
    const int blk = c >> 8, cc = c & 255;
    const v2u uw = *(const GAS v2u*)(p.UC + (size_t)r * BR + c);
    const v2u aw = *(const GAS v2u*)(p.RI + (size_t)r * 4096 + blk * 512 + cc);
    const v2u xw = *(const GAS v2u*)(p.RI + (size_t)r * 4096 + blk * 512 + 256 + cc);
    const float u[4] = {bflo(uw.x), bfhi(uw.x), bflo(uw.y), bfhi(uw.y)};
    const float la[4] = {bflo(aw.x), bfhi(aw.x), bflo(aw.y), bfhi(aw.y)};
    const float lx[4] = {bflo(xw.x), bfhi(xw.x), bflo(xw.y), bfhi(xw.y)};
#pragma unroll
    for (int e = 0; e < 4; ++e) { const float rr = sigmoid_f(la[e] + ba[e]), ii = sigmoid_f(lx[e] + bx[e]); const float log_a = -8.0f * rr * sp[e];
        a[e] = expf(log_a); bb[e] = sqrtf(-expm1f(2.0f * log_a)) * (ii * u[e]); }
}
__device__ __forceinline__ void rg_scan_a(const Frame& F, const RgPar& p, float* CA, float* CB) {
    for (int it = F.gt; it < BP * 32 * 512; it += F.NGT) {
        const int c = (it & 511) * 4, ch = (it >> 9) & 31, b = it >> 14;
        float sp[4], ba[4], bx[4];
#pragma unroll
        for (int e = 0; e < 4; ++e) { sp[e] = softplus_f(-p.lam[c + e]); ba[e] = p.ba[c + e]; bx[e] = p.bx[c + e]; }
        float A[4] = {1.f, 1.f, 1.f, 1.f}, H[4] = {0.f, 0.f, 0.f, 0.f};
        const int r0 = b * LP + ch * 64;
        for (int t = 0; t < 64; ++t) { float a[4], bb[4]; rg_ab(p, r0 + t, c, sp, ba, bx, a, bb);
#pragma unroll
            for (int e = 0; e < 4; ++e) { H[e] = a[e] * H[e] + bb[e]; A[e] *= a[e]; } }
        const size_t o = ((size_t)(b * 32 + ch)) * BR + c;
        *(GAS f32x4*)(CA + o) = (f32x4){A[0], A[1], A[2], A[3]}; *(GAS f32x4*)(CB + o) = (f32x4){H[0], H[1], H[2], H[3]};
    }
}
__device__ __forceinline__ void rg_scan_b(const Frame& F, const RgPar& p, const float* CA, const float* CB, const float* h0s, bf16* HG, float* outp, float* outs) {
    const int NP = BP * 32 * 512, NS = BS * 512;
    for (int it = F.gt; it < NP + NS; it += F.NGT) {
        int c, r0, nt; float H[4]; float* fin;
        if (it < NP) { c = (it & 511) * 4; const int ch = (it >> 9) & 31, b = it >> 14; r0 = b * LP + ch * 64; nt = 64;
            H[0] = H[1] = H[2] = H[3] = 0.f;
            for (int j = 0; j < ch; ++j) { const size_t o = ((size_t)(b * 32 + j)) * BR + c; const f32x4 Aj = *(const GAS f32x4*)(CA + o), Bj = *(const GAS f32x4*)(CB + o);
                H[0] = Aj.x * H[0] + Bj.x; H[1] = Aj.y * H[1] + Bj.y; H[2] = Aj.z * H[2] + Bj.z; H[3] = Aj.w * H[3] + Bj.w; }
            fin = (ch == 31) ? outp + (size_t)b * BR + c : nullptr;
        } else { const int is = it - NP; c = (is & 511) * 4; const int b = is >> 9; r0 = MP + b * LS; nt = LS;
            const f32x4 h0 = *(const GAS f32x4*)(h0s + (size_t)b * BR + c); H[0] = h0.x; H[1] = h0.y; H[2] = h0.z; H[3] = h0.w;
            fin = outs + (size_t)b * BR + c; }
        float sp[4], ba[4], bx[4];
#pragma unroll
        for (int e = 0; e < 4; ++e) { sp[e] = softplus_f(-p.lam[c + e]); ba[e] = p.ba[c + e]; bx[e] = p.bx[c + e]; }
        for (int t = 0; t < nt; ++t) { float a[4], bb[4]; const int r = r0 + t; rg_ab(p, r, c, sp, ba, bx, a, bb);
            const v2u gw = *(const GAS v2u*)(p.P + (size_t)r * 4096 + 2048 + c);
            const float gt[4] = {bflo(gw.x), bfhi(gw.x), bflo(gw.y), bfhi(gw.y)};
            float o[4];
#pragma unroll
            for (int e = 0; e < 4; ++e) { H[e] = a[e] * H[e] + bb[e]; o[e] = H[e] * silu_f(gt[e]); }
            v2u w; w.x = pk2(o[0], o[1]); w.y = pk2(o[2], o[3]); *(GAS v2u*)(HG + (size_t)r * BR + c) = w; }
        if (fin) *(GAS f32x4*)fin = (f32x4){H[0], H[1], H[2], H[3]};
    }
}

__device__ __forceinline__ int q_next(gu32* ctr, volatile LAS unsigned* slot, int tid) {
    __syncthreads();
    if (tid == 0) *slot = __hip_atomic_fetch_add(ctr, 1u, RLX_AGENT);
    __syncthreads();
    return (int)*slot;
}
typedef short bf16x4 __attribute__((ext_vector_type(4)));
__device__ __forceinline__ bf16x4 cvt4(const f32x4 v) { v2u w; w.x = pg8::cvt_pk_bf16(v.x, v.y); w.y = pg8::cvt_pk_bf16(v.z, v.w); return __builtin_bit_cast(bf16x4, w); }
#define MFMA16(a, b, c) __builtin_amdgcn_mfma_f32_16x16x16bf16_1k(a, b, c, 0, 0, 0)
#define MFMA32(a, b, c) __builtin_amdgcn_mfma_f32_16x16x32_bf16(a, b, c, 0, 0, 0)

__device__ __forceinline__ void ssd_dt_phase(const Frame& F, const bf16* P, const float* dt_bias, float* DT) {
    for (int it = F.gt; it < MT * SSD_H; it += F.NGT) { const int r = it >> 5, h = it & 31; DT[it] = softplus_f(bf2f(P[(size_t)r * SSD_NPAD + 6144 + h]) + dt_bias[h]); }
}
__device__ __forceinline__ void ssd_scan(const Frame& F, const bf16* XBC, const float* DT, const float* a_log, const float* s0s, float* YG, float* outs, gu32* qctr) {
    LAS float* Bs = (LAS float*)F.lds;
    LAS float* Cs = Bs + 8 * 128;
    LAS float* Xs = Cs + 8 * 128;
    LAS float* Ys = Xs + 8 * 64;
    LAS float* dts = Ys + 8 * 64;
    LAS float* dAs = dts + 8;
    const int tid = F.tid, p = tid >> 3, nq = tid & 7;
    for (;;) {
        const int su = q_next(qctr, (volatile LAS unsigned*)(F.lds + MISC_OFF + 64), tid);
        if (su >= BS * SSD_H) break;
        const int b = su >> 5, h = su & 31, row0 = MP + b * LS; float* sdst = outs + ((size_t)(b * SSD_H + h) * SSD_P + p) * SSD_N; float S[4][4];
        { const float* sp = s0s + ((size_t)(b * SSD_H + h) * SSD_P + p) * SSD_N;
#pragma unroll
          for (int i = 0; i < 4; ++i) { const f32x4 v = *(const GAS f32x4*)(sp + 32 * i + 4 * nq); S[i][0] = v.x; S[i][1] = v.y; S[i][2] = v.z; S[i][3] = v.w; } }
        const int g = h >> 2; const float ah = -expf(a_log[h]);
        if (tid < 128) { const int t = tid >> 4, v = tid & 15; const size_t ro = (size_t)(row0 + t) * SSD_CONV; float f[8];
            unpack8(*(const GAS v4u*)(XBC + ro + 2048 + g * 128 + 8 * v), f); *(LAS f32x4*)(Bs + t * 128 + 8 * v) = (f32x4){f[0], f[1], f[2], f[3]}; *(LAS f32x4*)(Bs + t * 128 + 8 * v + 4) = (f32x4){f[4], f[5], f[6], f[7]};
            unpack8(*(const GAS v4u*)(XBC + ro + 3072 + g * 128 + 8 * v), f); *(LAS f32x4*)(Cs + t * 128 + 8 * v) = (f32x4){f[0], f[1], f[2], f[3]}; *(LAS f32x4*)(Cs + t * 128 + 8 * v + 4) = (f32x4){f[4], f[5], f[6], f[7]}; }
        else if (tid < 192) { const int t = (tid - 128) >> 3, v = tid & 7; float f[8]; unpack8(*(const GAS v4u*)(XBC + (size_t)(row0 + t) * SSD_CONV + h * 64 + 8 * v), f);
            *(LAS f32x4*)(Xs + t * 64 + 8 * v) = (f32x4){f[0], f[1], f[2], f[3]}; *(LAS f32x4*)(Xs + t * 64 + 8 * v + 4) = (f32x4){f[4], f[5], f[6], f[7]}; }
        else if (tid < 200) { const int t = tid - 192; const float d = DT[(size_t)(row0 + t) * SSD_H + h]; dts[t] = d; dAs[t] = expf(d * ah); }
        __syncthreads();
#pragma unroll
        for (int t = 0; t < LS; ++t) {
            const float dA = dAs[t], xdt = Xs[t * 64 + p] * dts[t];
            float acc = 0.f;
#pragma unroll
            for (int i = 0; i < 4; ++i) { const f32x4 bv = *(const LAS f32x4*)(Bs + t * 128 + 32 * i + 4 * nq), cv = *(const LAS f32x4*)(Cs + t * 128 + 32 * i + 4 * nq);
                S[i][0] = dA * S[i][0] + xdt * bv.x; S[i][1] = dA * S[i][1] + xdt * bv.y; S[i][2] = dA * S[i][2] + xdt * bv.z; S[i][3] = dA * S[i][3] + xdt * bv.w;
                acc += (S[i][0] * cv.x + S[i][1] * cv.y) + (S[i][2] * cv.z + S[i][3] * cv.w); }
            acc += __shfl_xor(acc, 1); acc += __shfl_xor(acc, 2); acc += __shfl_xor(acc, 4);
            if (nq == 0) Ys[t * 64 + p] = acc;
        }
        __syncthreads();
        if (tid < 128) { const int t = tid >> 4, v4 = (tid & 15) * 4; *(GAS f32x4*)(YG + (size_t)(row0 + t) * BR + h * 64 + v4) = *(const LAS f32x4*)(Ys + t * 64 + v4); }
#pragma unroll
        for (int i = 0; i < 4; ++i) *(GAS f32x4*)(sdst + 32 * i + 4 * nq) = (f32x4){S[i][0], S[i][1], S[i][2], S[i][3]};
    }
}
constexpr int SSP_QP = 136;
constexpr int SSP_BM = 64 * SSP_QP * 2, SSP_BT = 2 * SSP_BM, SSP_XWT = SSP_BT + 16384, SSP_XDT = SSP_XWT + 8192, SSP_ACS = SSP_XDT + 8192, SSP_BUF = SSP_ACS + 256;
static_assert(2 * SSP_BUF <= LDSCTL_OFF, "ssd prompt LDS");
__device__ __forceinline__ void ssp_load_raw(const bf16* xbc_row, const float* dt_row, int g, int h, int ch, unsigned short (&rb)[16], unsigned short (&rc)[16], unsigned short (&rx)[16], float (&dt)[16]) {
#pragma unroll
    for (int t = 0; t < 16; ++t) { const GAS bf16* q = (const GAS bf16*)(xbc_row + (size_t)t * SSD_CONV); rb[t] = q[2048 + g * 128 + ch]; rc[t] = q[3072 + g * 128 + ch]; rx[t] = q[h * 64 + (ch & 63)]; dt[t] = ((const GAS float*)dt_row)[t * SSD_H + h]; }
}
__device__ __forceinline__ void ssp_stage(LAS unsigned char* buf, int blk, int ch, float ah, const unsigned short (&rb)[16], const unsigned short (&rc)[16], const unsigned short (&rx)[16], const float (&dt)[16]) {
    LAS bf16* CM = (LAS bf16*)buf; LAS bf16* BM = (LAS bf16*)(buf + SSP_BM);
#pragma unroll
    for (int t = 0; t < 16; ++t) { CM[(blk * 16 + t) * SSP_QP + ch] = rc[t]; BM[(blk * 16 + t) * SSP_QP + ch] = rb[t]; }
    v4u w0, w1;
    w0.x = rb[0] | ((unsigned)rb[1] << 16); w0.y = rb[2] | ((unsigned)rb[3] << 16); w0.z = rb[4] | ((unsigned)rb[5] << 16); w0.w = rb[6] | ((unsigned)rb[7] << 16);
    w1.x = rb[8] | ((unsigned)rb[9] << 16); w1.y = rb[10] | ((unsigned)rb[11] << 16); w1.z = rb[12] | ((unsigned)rb[13] << 16); w1.w = rb[14] | ((unsigned)rb[15] << 16);
    LAS v4u* bt = (LAS v4u*)(buf + SSP_BT + (blk * 128 + ch) * 32); bt[0] = w0; bt[1] = w1;
    if (ch < 64) {
        float acs[16]; float run = 0.f;
#pragma unroll
        for (int t = 0; t < 16; ++t) { run += dt[t] * ah; acs[t] = run; }
        float xd[16], xw[16];
#pragma unroll
        for (int t = 0; t < 16; ++t) { xd[t] = bf2f(rx[t]) * dt[t]; xw[t] = xd[t] * __expf(acs[15] - acs[t]); }
        w0.x = pk2(xw[0], xw[1]); w0.y = pk2(xw[2], xw[3]); w0.z = pk2(xw[4], xw[5]); w0.w = pk2(xw[6], xw[7]); w1.x = pk2(xw[8], xw[9]); w1.y = pk2(xw[10], xw[11]); w1.z = pk2(xw[12], xw[13]); w1.w = pk2(xw[14], xw[15]);
        LAS v4u* xwt = (LAS v4u*)(buf + SSP_XWT + (blk * 64 + ch) * 32); xwt[0] = w0; xwt[1] = w1;
        w0.x = pk2(xd[0], xd[1]); w0.y = pk2(xd[2], xd[3]); w0.z = pk2(xd[4], xd[5]); w0.w = pk2(xd[6], xd[7]); w1.x = pk2(xd[8], xd[9]); w1.y = pk2(xd[10], xd[11]); w1.z = pk2(xd[12], xd[13]); w1.w = pk2(xd[14], xd[15]);
        LAS v4u* xdt = (LAS v4u*)(buf + SSP_XDT + (blk * 64 + ch) * 32); xdt[0] = w0; xdt[1] = w1;
        if (ch == 0) { LAS float* A = (LAS float*)(buf + SSP_ACS) + blk * 16;
#pragma unroll
            for (int t = 0; t < 16; ++t) A[t] = acs[t]; }
    }
}
__device__ __forceinline__ void ssd_prompt(const Frame& F, const bf16* XBC, const float* DT, const float* a_log, float* YG, float* YG2, float* outp) {
    const int tid = F.tid, lane = F.lane, wave = F.wave, l15 = lane & 15, lq = lane >> 4;
    const int blk = tid >> 7, ch = tid & 127;
    for (int ui = blockIdx.x; ui < BP * SSD_H; ui += F.G) {
        const int b = ui >> 5, h = ui & 31, g = h >> 2; const size_t row0 = (size_t)b * LP;
        const float ah = -expf(a_log[h]);
        f32x4 S[8];
#pragma unroll
        for (int nb = 0; nb < 8; ++nb) S[nb] = (f32x4){0.f, 0.f, 0.f, 0.f};
        unsigned short rb[16], rc[16], rx[16]; float dt[16];
        const bf16* xrow = XBC + (row0 + blk * 16) * SSD_CONV; const float* dtrow = DT + (row0 + blk * 16) * SSD_H;
        ssp_load_raw(xrow, dtrow, g, h, ch, rb, rc, rx, dt);
        __syncthreads();
        ssp_stage(F.lds, blk, ch, ah, rb, rc, rx, dt);
        __syncthreads();
        for (int st = 0; st < LP / 64; ++st) {
            LAS unsigned char* buf = F.lds + (st & 1) * SSP_BUF;
            if (st + 1 < LP / 64) ssp_load_raw(xrow + (size_t)(st + 1) * 64 * SSD_CONV, dtrow + (size_t)(st + 1) * 64 * SSD_H, g, h, ch, rb, rc, rx, dt);
            const LAS bf16* CM = (const LAS bf16*)buf; const LAS bf16* BM = (const LAS bf16*)(buf + SSP_BM); const LAS float* ACS = (const LAS float*)(buf + SSP_ACS);
            if (wave < 4) {
                const int pb = wave;
#pragma unroll 1
                for (int bk = 0; bk < 4; ++bk) {
                    const LAS bf16* crow = CM + (bk * 16 + l15) * SSP_QP;
                    f32x4 yo = (f32x4){0.f, 0.f, 0.f, 0.f};
#pragma unroll
                    for (int nb = 0; nb < 8; ++nb) yo = MFMA16(cvt4(S[nb]), *(const LAS bf16x4*)(crow + nb * 16 + 4 * lq), yo);
                    const float ea = __expf(ACS[bk * 16 + l15]);
                    *(GAS f32x4*)(YG + (row0 + st * 64 + bk * 16 + l15) * BR + h * 64 + 16 * pb + 4 * lq) = yo * ea;
                    const float dab = __expf(ACS[bk * 16 + 15]);
                    const bf16x4 xw = *(const LAS bf16x4*)(buf + SSP_XWT + ((bk * 64 + 16 * pb + l15) * 16 + 4 * lq) * 2);
#pragma unroll
                    for (int nb = 0; nb < 8; ++nb) S[nb] = MFMA16(*(const LAS bf16x4*)(buf + SSP_BT + ((bk * 128 + nb * 16 + l15) * 16 + 4 * lq) * 2), xw, S[nb] * dab);
                }
            } else {
                const int bk = wave - 4;
                const LAS bf16* crow = CM + (bk * 16 + l15) * SSP_QP; const LAS bf16* brow = BM + (bk * 16 + l15) * SSP_QP;
                f32x4 gt = (f32x4){0.f, 0.f, 0.f, 0.f};
#pragma unroll
                for (int ks = 0; ks < 4; ++ks) gt = MFMA32(*(const LAS bf16x8*)(brow + ks * 32 + 8 * lq), *(const LAS bf16x8*)(crow + ks * 32 + 8 * lq), gt);
                const float at = ACS[bk * 16 + l15]; const f32x4 as = *(const LAS f32x4*)(ACS + bk * 16 + 4 * lq);
                gt.x = (4 * lq + 0 <= l15) ? gt.x * __expf(at - as.x) : 0.f; gt.y = (4 * lq + 1 <= l15) ? gt.y * __expf(at - as.y) : 0.f;
                gt.z = (4 * lq + 2 <= l15) ? gt.z * __expf(at - as.z) : 0.f; gt.w = (4 * lq + 3 <= l15) ? gt.w * __expf(at - as.w) : 0.f;
                const bf16x4 lb4 = cvt4(gt);
#pragma unroll
                for (int pb = 0; pb < 4; ++pb) { const f32x4 yd = MFMA16(*(const LAS bf16x4*)(buf + SSP_XDT + ((bk * 64 + 16 * pb + l15) * 16 + 4 * lq) * 2), lb4, ((f32x4){0.f, 0.f, 0.f, 0.f}));
                    *(GAS f32x4*)(YG2 + (row0 + st * 64 + bk * 16 + l15) * BR + h * 64 + 16 * pb + 4 * lq) = yd; }
            }
            if (st + 1 < LP / 64) ssp_stage(F.lds + ((st + 1) & 1) * SSP_BUF, blk, ch, ah, rb, rc, rx, dt);
            __syncthreads();
        }
        if (wave < 4) { float* sd = outp + ((size_t)(b * SSD_H + h) * SSD_P + 16 * wave + l15) * SSD_N + 4 * lq;
#pragma unroll
            for (int nb = 0; nb < 8; ++nb) *(GAS f32x4*)(sd + nb * 16) = S[nb]; }
    }
}
__device__ __forceinline__ void ssd_norm(const Frame& F, const float* YG, const float* YG2, const bf16* XBC, const bf16* P, const float* dsk, bf16* HG) {
    for (int r = F.gw; r < MT; r += F.NGW) {
        const GAS f32x4* yr = (const GAS f32x4*)(YG + (size_t)r * BR) + F.lane; const GAS f32x4* y2 = (const GAS f32x4*)(YG2 + (size_t)r * BR) + F.lane; GAS v2u* o8 = (GAS v2u*)(HG + (size_t)r * BR) + F.lane;
        const GAS v2u* x8 = (const GAS v2u*)(XBC + (size_t)r * SSD_CONV) + F.lane; const GAS v2u* z8 = (const GAS v2u*)(P + (size_t)r * SSD_NPAD) + F.lane;
#pragma unroll
        for (int j = 0; j < 8; ++j) { f32x4 v = yr[64 * j]; if (r < MP) v = v + y2[64 * j];
            const float Dh = dsk[(256 * j + 4 * F.lane) >> 6]; const v2u xw = x8[64 * j], zw = z8[64 * j];
            v.x = (v.x + Dh * bflo(xw.x)) * silu_f(bflo(zw.x)); v.y = (v.y + Dh * bfhi(xw.x)) * silu_f(bfhi(zw.x)); v.z = (v.z + Dh * bflo(xw.y)) * silu_f(bflo(zw.y)); v.w = (v.w + Dh * bfhi(xw.y)) * silu_f(bfhi(zw.y));
            const float sq = wave_sum((v.x * v.x + v.y * v.y) + (v.z * v.z + v.w * v.w)); const float rstd = 1.0f / sqrtf(sq * (1.f / 256.f) + EPS);
            v2u w; w.x = pk2(v.x * rstd, v.y * rstd); w.y = pk2(v.z * rstd, v.w * rstd); o8[64 * j] = w; }
    }
}

constexpr int HGP_QP = 136;
constexpr int HGP_KG = 64 * HGP_QP * 2, HGP_KDT = 2 * HGP_KG, HGP_VT = HGP_KDT + 16384, HGP_GL = HGP_VT + 16384, HGP_BUF = HGP_GL + 2048;
static_assert(2 * HGP_BUF <= LDSCTL_OFF, "hgrn prompt LDS");
__device__ __forceinline__ void hgp_load_raw(const bf16* p, unsigned short (&rq)[16], unsigned short (&rf)[16], unsigned short (&rv)[16]) {
#pragma unroll
    for (int t = 0; t < 16; ++t) { const GAS bf16* q = (const GAS bf16*)(p + (size_t)t * 8192); rq[t] = q[0]; rf[t] = q[2048]; rv[t] = q[4096]; }
}
__device__ __forceinline__ void hgp_stage(LAS unsigned char* buf, int blk, int ch, float lb, const unsigned short (&rq)[16], const unsigned short (&rf)[16], const unsigned short (&rv)[16]) {
    float G[16], kk[16]; float run = 0.f; const float omlb = 1.0f - lb;
#pragma unroll
    for (int t = 0; t < 16; ++t) { const float sg = sigmoid_f(bf2f(rf[t])); const float fo = lb + omlb * sg; run += __logf(fo); G[t] = run; kk[t] = omlb * (1.0f - sg); }
    LAS bf16* QG = (LAS bf16*)buf; LAS bf16* KG = (LAS bf16*)(buf + HGP_KG);
    float kd[16];
#pragma unroll
    for (int t = 0; t < 16; ++t) { const float e = __expf(G[t]); const float qg = silu_f(bf2f(rq[t])) * e; const float kg = kk[t] * __expf(-G[t]); kd[t] = kk[t] * __expf(G[15] - G[t]);
        QG[(blk * 16 + t) * HGP_QP + ch] = (bf16)f2bf(qg); KG[(blk * 16 + t) * HGP_QP + ch] = (bf16)f2bf(kg); }
    v4u w0, w1;
    w0.x = pk2(kd[0], kd[1]); w0.y = pk2(kd[2], kd[3]); w0.z = pk2(kd[4], kd[5]); w0.w = pk2(kd[6], kd[7]); w1.x = pk2(kd[8], kd[9]); w1.y = pk2(kd[10], kd[11]); w1.z = pk2(kd[12], kd[13]); w1.w = pk2(kd[14], kd[15]);
    LAS v4u* kdt = (LAS v4u*)(buf + HGP_KDT + (blk * 128 + ch) * 32); kdt[0] = w0; kdt[1] = w1;
    w0.x = rv[0] | ((unsigned)rv[1] << 16); w0.y = rv[2] | ((unsigned)rv[3] << 16); w0.z = rv[4] | ((unsigned)rv[5] << 16); w0.w = rv[6] | ((unsigned)rv[7] << 16);
    w1.x = rv[8] | ((unsigned)rv[9] << 16); w1.y = rv[10] | ((unsigned)rv[11] << 16); w1.z = rv[12] | ((unsigned)rv[13] << 16); w1.w = rv[14] | ((unsigned)rv[15] << 16);
    LAS v4u* vt = (LAS v4u*)(buf + HGP_VT + (blk * 128 + ch) * 32); vt[0] = w0; vt[1] = w1;
    ((LAS float*)(buf + HGP_GL))[blk * 128 + ch] = __expf(G[15]);
}
__device__ __forceinline__ void hgrn_prompt(const Frame& F, const bf16* P, const float* LBl, float* OH, float* outp) {
    const int tid = F.tid, lane = F.lane, wave = F.wave, l15 = lane & 15, lq = lane >> 4;
    const int blk = tid >> 7, ch = tid & 127;
    for (int ui = blockIdx.x; ui < BP * HG_H; ui += F.G) {
        const int b = ui >> 4, h = ui & 15; const size_t row0 = (size_t)b * LP;
        const float lb = LBl[h * 128 + ch];
        f32x4 S[8];
#pragma unroll
        for (int kb = 0; kb < 8; ++kb) S[kb] = (f32x4){0.f, 0.f, 0.f, 0.f};
        unsigned short rq[16], rf[16], rv[16];
        const bf16* pbase = P + (row0 + blk * 16) * 8192 + h * 128 + ch;
        hgp_load_raw(pbase, rq, rf, rv);
        __syncthreads();
        hgp_stage(F.lds, blk, ch, lb, rq, rf, rv);
        __syncthreads();
        for (int st = 0; st < LP / 64; ++st) {
            LAS unsigned char* buf = F.lds + (st & 1) * HGP_BUF;
            if (st + 1 < LP / 64) hgp_load_raw(pbase + (size_t)(st + 1) * 64 * 8192, rq, rf, rv);
            const LAS bf16* QG = (const LAS bf16*)buf; const LAS bf16* KG = (const LAS bf16*)(buf + HGP_KG);
#pragma unroll 1
            for (int bk = 0; bk < 4; ++bk) {
                const LAS bf16* qrow = QG + (bk * 16 + l15) * HGP_QP; const LAS bf16* krow = KG + (bk * 16 + l15) * HGP_QP;
                f32x4 at = (f32x4){0.f, 0.f, 0.f, 0.f};
#pragma unroll
                for (int ks = 0; ks < 4; ++ks) at = MFMA32(*(const LAS bf16x8*)(krow + ks * 32 + 8 * lq), *(const LAS bf16x8*)(qrow + ks * 32 + 8 * lq), at);
                at.x = (4 * lq + 0 <= l15) ? at.x : 0.f; at.y = (4 * lq + 1 <= l15) ? at.y : 0.f; at.z = (4 * lq + 2 <= l15) ? at.z : 0.f; at.w = (4 * lq + 3 <= l15) ? at.w : 0.f;
                const bf16x4 attb = cvt4(at);
                f32x4 o = (f32x4){0.f, 0.f, 0.f, 0.f};
#pragma unroll
                for (int kb = 0; kb < 8; ++kb) o = MFMA16(cvt4(S[kb]), *(const LAS bf16x4*)(qrow + kb * 16 + 4 * lq), o);
                const bf16x4 vfrag = *(const LAS bf16x4*)(buf + HGP_VT + ((bk * 128 + 16 * wave + l15) * 16 + 4 * lq) * 2);
                o = MFMA16(vfrag, attb, o);
                *(GAS f32x4*)(OH + (row0 + st * 64 + bk * 16 + l15) * BR + h * 128 + 16 * wave + 4 * lq) = o;
#pragma unroll
                for (int kb = 0; kb < 8; ++kb) { const f32x4 gl = *(const LAS f32x4*)(buf + HGP_GL + (bk * 128 + kb * 16 + 4 * lq) * 4);
                    S[kb] = MFMA16(*(const LAS bf16x4*)(buf + HGP_KDT + ((bk * 128 + kb * 16 + l15) * 16 + 4 * lq) * 2), vfrag, S[kb] * gl); }
            }
            if (st + 1 < LP / 64) hgp_stage(F.lds + ((st + 1) & 1) * HGP_BUF, blk, ch, lb, rq, rf, rv);
            __syncthreads();
        }
        float* sd = outp + ((size_t)(b * HG_H + h) * HG_DK) * HG_DV + 16 * wave + l15;
#pragma unroll
        for (int kb = 0; kb < 8; ++kb) { sd[(size_t)(kb * 16 + 4 * lq + 0) * HG_DV] = S[kb].x; sd[(size_t)(kb * 16 + 4 * lq + 1) * HG_DV] = S[kb].y; sd[(size_t)(kb * 16 + 4 * lq + 2) * HG_DV] = S[kb].z; sd[(size_t)(kb * 16 + 4 * lq + 3) * HG_DV] = S[kb].w; }
    }
}
__device__ __forceinline__ void hgrn_scan(const Frame& F, const bf16* P, const float* LBl, const float* s0s, float* OH, float* outs, gu32* qctr) {
    LAS float* Fs = (LAS float*)F.lds;
    LAS float* Ks = Fs + 32 * 128;
    LAS float* Qs = Ks + 32 * 128;
    LAS float* Vs = Qs + 32 * 128;
    LAS float* Pt = Vs + 32 * 64;
    const int tid = F.tid, dvq = tid & 15, dkq = tid >> 4, wave = F.wave, lane = F.lane;
    for (;;) {
        const int su = q_next(qctr, (volatile LAS unsigned*)(F.lds + MISC_OFF + 64), tid);
        if (su >= BS * HG_H * 2) break;
        int b, h, half, L, row0; float* sdst; float S[4][4];
        { b = su >> 5; h = (su >> 1) & 15; half = su & 1; L = LS; row0 = MP + b * LS; sdst = outs;
#pragma unroll
            for (int i = 0; i < 4; ++i) { const f32x4 v = *(const GAS f32x4*)(s0s + ((size_t)(b * HG_H + h) * HG_DK + 4 * dkq + i) * HG_DV + half * 64 + 4 * dvq); S[i][0] = v.x; S[i][1] = v.y; S[i][2] = v.z; S[i][3] = v.w; }
        }
        sdst += ((size_t)(b * HG_H + h) * HG_DK + 4 * dkq) * HG_DV + half * 64 + 4 * dvq;
        for (int c0 = 0; c0 < L; c0 += 32) {
            const int tn = (L - c0) < 32 ? (L - c0) : 32;
            { const int t = tid >> 4, v = tid & 15;
              if (t < tn) { const size_t ro = (size_t)(row0 + c0 + t) * 8192; float q[8], f[8];
                  unpack8(*(const GAS v4u*)(P + ro + h * 128 + 8 * v), q); unpack8(*(const GAS v4u*)(P + ro + 2048 + h * 128 + 8 * v), f);
                  float fo[8], ko[8], qo[8];
#pragma unroll
                  for (int e = 0; e < 8; ++e) { const float lb = LBl[h * 128 + 8 * v + e]; const float sg = sigmoid_f(f[e]); fo[e] = lb + (1.0f - lb) * sg; ko[e] = (1.0f - lb) * (1.0f - sg); qo[e] = silu_f(q[e]); }
                  *(LAS f32x4*)(Fs + t * 128 + 8 * v) = (f32x4){fo[0], fo[1], fo[2], fo[3]}; *(LAS f32x4*)(Fs + t * 128 + 8 * v + 4) = (f32x4){fo[4], fo[5], fo[6], fo[7]};
                  *(LAS f32x4*)(Ks + t * 128 + 8 * v) = (f32x4){ko[0], ko[1], ko[2], ko[3]}; *(LAS f32x4*)(Ks + t * 128 + 8 * v + 4) = (f32x4){ko[4], ko[5], ko[6], ko[7]};
                  *(LAS f32x4*)(Qs + t * 128 + 8 * v) = (f32x4){qo[0], qo[1], qo[2], qo[3]}; *(LAS f32x4*)(Qs + t * 128 + 8 * v + 4) = (f32x4){qo[4], qo[5], qo[6], qo[7]}; } }
            if (tid < 256) { const int t = tid >> 3, v = tid & 7;
              if (t < tn) { float f[8]; unpack8(*(const GAS v4u*)(P + (size_t)(row0 + c0 + t) * 8192 + 4096 + h * 128 + half * 64 + 8 * v), f);
                  *(LAS f32x4*)(Vs + t * 64 + 8 * v) = (f32x4){f[0], f[1], f[2], f[3]}; *(LAS f32x4*)(Vs + t * 64 + 8 * v + 4) = (f32x4){f[4], f[5], f[6], f[7]}; } }
            __syncthreads();
            for (int t = 0; t < tn; ++t) {
                const f32x4 fv = *(const LAS f32x4*)(Fs + t * 128 + 4 * dkq), kv = *(const LAS f32x4*)(Ks + t * 128 + 4 * dkq), qv = *(const LAS f32x4*)(Qs + t * 128 + 4 * dkq), vv = *(const LAS f32x4*)(Vs + t * 64 + 4 * dvq);
                const float ff[4] = {fv.x, fv.y, fv.z, fv.w}, kk[4] = {kv.x, kv.y, kv.z, kv.w}, qq[4] = {qv.x, qv.y, qv.z, qv.w};
                float acc[4] = {0.f, 0.f, 0.f, 0.f};
#pragma unroll
                for (int i = 0; i < 4; ++i) { S[i][0] = ff[i] * S[i][0] + kk[i] * vv.x; S[i][1] = ff[i] * S[i][1] + kk[i] * vv.y; S[i][2] = ff[i] * S[i][2] + kk[i] * vv.z; S[i][3] = ff[i] * S[i][3] + kk[i] * vv.w;
                    acc[0] += qq[i] * S[i][0]; acc[1] += qq[i] * S[i][1]; acc[2] += qq[i] * S[i][2]; acc[3] += qq[i] * S[i][3]; }
#pragma unroll
                for (int e = 0; e < 4; ++e) { acc[e] += __shfl_xor(acc[e], 16); acc[e] += __shfl_xor(acc[e], 32); }
                if (lane < 16) *(LAS f32x4*)(Pt + (t * 8 + wave) * 64 + 4 * dvq) = (f32x4){acc[0], acc[1], acc[2], acc[3]};
            }
            __syncthreads();
            { const int t = tid >> 4, d4 = (tid & 15) * 4;
              if (t < tn) { f32x4 s = (f32x4){0.f, 0.f, 0.f, 0.f};
#pragma unroll
                  for (int w = 0; w < 8; ++w) s = s + *(const LAS f32x4*)(Pt + (t * 8 + w) * 64 + d4);
                  *(GAS f32x4*)(OH + (size_t)(row0 + c0 + t) * BR + h * 128 + half * 64 + d4) = s; } }
            __syncthreads();
        }
#pragma unroll
        for (int i = 0; i < 4; ++i) *(GAS f32x4*)(sdst + (size_t)i * HG_DV) = (f32x4){S[i][0], S[i][1], S[i][2], S[i][3]};
    }
}
__device__ __forceinline__ void hgrn_norm(const Frame& F, const float* OH, const bf16* P, bf16* HG) {
    for (int r = F.gw; r < MT; r += F.NGW) {
        const GAS f32x4* orow = (const GAS f32x4*)(OH + (size_t)r * BR) + F.lane; GAS v2u* o8 = (GAS v2u*)(HG + (size_t)r * BR) + F.lane;
        const GAS v2u* g8 = (const GAS v2u*)(P + (size_t)r * 8192 + 6144) + F.lane;
#pragma unroll
        for (int j = 0; j < 8; ++j) { const f32x4 v = orow[64 * j]; float s = (v.x * v.x + v.y * v.y) + (v.z * v.z + v.w * v.w);
            s += __shfl_xor(s, 1); s += __shfl_xor(s, 2); s += __shfl_xor(s, 4); s += __shfl_xor(s, 8); s += __shfl_xor(s, 16);
            const float rstd = 1.0f / sqrtf(s * (1.f / 128.f) + EPS); const v2u gw = g8[64 * j];
            v2u w; w.x = pk2(v.x * rstd * silu_f(bflo(gw.x)), v.y * rstd * silu_f(bfhi(gw.x))); w.y = pk2(v.z * rstd * silu_f(bflo(gw.y)), v.w * rstd * silu_f(bfhi(gw.y))); o8[64 * j] = w; }
    }
}

struct RgF { const bf16* P; const bf16* Wax; const float* cw; const float* cb; const float* ba; const float* bx; const float* lam; const float* st_conv; const float* st_h;
             bf16* HG; float* rgc_p; float* rgc_s; float* rgh_p; float* rgh_s; };
constexpr int RGF_UP = 264, RGF_LGP = 132;
constexpr int RGF_LG = 64 * RGF_UP * 2, RGF_SEG = RGF_LG + 64 * RGF_LGP * 4, RGF_HC = RGF_SEG + 8 * 64 * 2 * 4;
__device__ __forceinline__ void rgf_load_raw(const RgF& p, int sample, int bt, int tile, int tq, size_t row0, int colb, v4u (&raw)[7]) {
#pragma unroll
    for (int m = 0; m < 7; ++m) {
        const int tl = tile * 64 + 4 * tq - 3 + m;
        if (sample && !(tq & 1) && m < 3) { const float* sp = p.st_conv + ((size_t)(bt * 8 + (tq >> 1)) * 3 + m) * BR + colb; const f32x4 s0 = *(const GAS f32x4*)sp, s1 = *(const GAS f32x4*)(sp + 4);
            raw[m].x = pk2(s0.x, s0.y); raw[m].y = pk2(s0.z, s0.w); raw[m].z = pk2(s1.x, s1.y); raw[m].w = pk2(s1.z, s1.w); }
        else if (tl >= 0) raw[m] = *(const GAS v4u*)(p.P + (row0 + tl) * 4096 + colb);
        else raw[m] = (v4u){0u, 0u, 0u, 0u};
    }
}
__device__ __forceinline__ void rg_fused(const Frame& F, const RgF& p, gu32* qctr) {
    LAS bf16* UC = (LAS bf16*)F.lds; LAS float* LG = (LAS float*)(F.lds + RGF_LG); LAS float* SEG = (LAS float*)(F.lds + RGF_SEG); LAS float* HC = (LAS float*)(F.lds + RGF_HC);
    const int tid = F.tid, lane = F.lane, wave = F.wave, l15 = lane & 15, lq = lane >> 4;
    const int tq = tid >> 5, v = tid & 31, c = tid & 63, sg = wave;
    int ui = blockIdx.x;
    for (;;) {
        int sample, bt, slice;
        if (ui < BP * 32) { sample = 0; bt = ui >> 5; slice = ui & 31; ui += F.G; }
        else { const int su = q_next(qctr, (volatile LAS unsigned*)(F.lds + MISC_OFF + 64), tid); if (su >= 16 * 32) break; sample = 1; bt = su >> 5; slice = su & 31; }
        const int j = slice >> 2, sq = slice & 3, chan = slice * 64 + c, colb = 256 * j + 8 * v;
        const int ntile = sample ? 1 : LP / 64; const size_t row0 = sample ? (size_t)MP + (size_t)bt * 64 : (size_t)bt * LP;
        float cw0[8], cw1[8], cw2[8], cw3[8], cbs[8];
#pragma unroll
        for (int e = 0; e < 8; ++e) { cw0[e] = p.cw[0 * BR + colb + e]; cw1[e] = p.cw[1 * BR + colb + e]; cw2[e] = p.cw[2 * BR + colb + e]; cw3[e] = p.cw[3 * BR + colb + e]; cbs[e] = p.cb[colb + e]; }
        bf16x8 Wf[8];
        { const bf16* wr = p.Wax + (size_t)(512 * j + (wave >> 2) * 256 + sq * 64 + 16 * (wave & 3) + l15) * 256 + 8 * lq;
#pragma unroll
          for (int ks = 0; ks < 8; ++ks) Wf[ks] = *(const GAS bf16x8*)(wr + ks * 32); }
        const float sp = softplus_f(-p.lam[chan]), ba = p.ba[chan], bx = p.bx[chan];
        v4u raw[7];
        rgf_load_raw(p, sample, bt, 0, tq, row0, colb, raw);
        __syncthreads();
        if (tid < 64) HC[tid] = 0.f;
        for (int tile = 0; tile < ntile; ++tile) {
            float u[7][8];
#pragma unroll
            for (int m = 0; m < 7; ++m) unpack8(raw[m], u[m]);
#pragma unroll
            for (int i = 0; i < 4; ++i) { float o[8];
#pragma unroll
                for (int e = 0; e < 8; ++e) o[e] = cbs[e] + cw0[e] * u[i][e] + cw1[e] * u[i + 1][e] + cw2[e] * u[i + 2][e] + cw3[e] * u[i + 3][e];
                *(LAS v4u*)(UC + (4 * tq + i) * RGF_UP + 8 * v) = pack8(o); }
            if ((v >> 3) == sq && (sample ? (tq & 1) : (tile == ntile - 1 && tq == 15))) {
                float* dst = sample ? p.rgc_s + ((size_t)(bt * 8 + (tq >> 1)) * 3) * BR + colb : p.rgc_p + ((size_t)bt * 3) * BR + colb;
#pragma unroll
                for (int i = 1; i < 4; ++i) { *(GAS f32x4*)(dst + (size_t)(i - 1) * BR) = (f32x4){u[i + 3][0], u[i + 3][1], u[i + 3][2], u[i + 3][3]}; *(GAS f32x4*)(dst + (size_t)(i - 1) * BR + 4) = (f32x4){u[i + 3][4], u[i + 3][5], u[i + 3][6], u[i + 3][7]}; } }
            __syncthreads();
            if (tile + 1 < ntile) rgf_load_raw(p, sample, bt, tile + 1, tq, row0, colb, raw);
            const size_t rseg = row0 + tile * 64 + 8 * sg;
            unsigned short gt[8];
#pragma unroll
            for (int tt = 0; tt < 8; ++tt) gt[tt] = *(const GAS bf16*)(p.P + (rseg + tt) * 4096 + 2048 + chan);
#pragma unroll
            for (int rb = 0; rb < 4; ++rb) { f32x4 acc = (f32x4){0.f, 0.f, 0.f, 0.f};
#pragma unroll
                for (int ks = 0; ks < 8; ++ks) acc = MFMA32(*(const LAS bf16x8*)(UC + (16 * rb + l15) * RGF_UP + ks * 32 + 8 * lq), Wf[ks], acc);
                LAS float* lg = LG + (16 * rb + 4 * lq) * RGF_LGP + 16 * wave + l15; lg[0] = acc.x; lg[RGF_LGP] = acc.y; lg[2 * RGF_LGP] = acc.z; lg[3 * RGF_LGP] = acc.w; }
            __syncthreads();
            float a_[8], b_[8]; float As = 1.f, Hs = 0.f;
#pragma unroll
            for (int tt = 0; tt < 8; ++tt) { const int t = 8 * sg + tt; const float la = LG[t * RGF_LGP + c] + ba, lx = LG[t * RGF_LGP + 64 + c] + bx; const float uu = bf2f(UC[t * RGF_UP + sq * 64 + c]);
                const float rr = sigmoid_f(la), ii = sigmoid_f(lx); const float a = __expf(-8.0f * rr * sp); const float bb = sqrtf(fmaxf(1.0f - a * a, 0.f)) * (ii * uu);
                a_[tt] = a; b_[tt] = bb; As *= a; Hs = a * Hs + bb; }
            SEG[(sg * 64 + c) * 2] = As; SEG[(sg * 64 + c) * 2 + 1] = Hs;
            __syncthreads();
            float h;
            if (sample) h = p.st_h[(size_t)(bt * 8 + sg) * BR + chan];
            else { h = HC[(tile & 1) * 64 + c];
                for (int jj = 0; jj < sg; ++jj) h = SEG[(jj * 64 + c) * 2] * h + SEG[(jj * 64 + c) * 2 + 1]; }
#pragma unroll
            for (int tt = 0; tt < 8; ++tt) { h = a_[tt] * h + b_[tt]; *(GAS bf16*)(p.HG + (rseg + tt) * BR + chan) = (bf16)f2bf(h * silu_f(bf2f(gt[tt]))); }
            if (sample) p.rgh_s[(size_t)(bt * 8 + sg) * BR + chan] = h;
            else if (sg == 7) { HC[((tile + 1) & 1) * 64 + c] = h; if (tile == ntile - 1) p.rgh_p[(size_t)bt * BR + chan] = h; }
        }
    }
}

__device__ __forceinline__ void attn_prompt(const Frame& F, const bf16* Q, const bf16* KP, const bf16* VT, bf16* O) {
    const int lane = F.lane, l15 = lane & 15, lq = lane >> 4;
    for (int ui = blockIdx.x; ui < BP * 4 * 16; ui += F.G) {
        const int qt = ui & 15, h = (ui >> 4) & 3, b = ui >> 6;
        const int r0 = b * LP + qt * 128 + F.wave * 16;
        bf16x8 Qb[8];
#pragma unroll
        for (int ks = 0; ks < 8; ++ks) Qb[ks] = *(const GAS bf16x8*)(Q + (size_t)(r0 + l15) * DM + h * 256 + ks * 32 + 8 * lq);
        f32x4 ST[16];
        const bf16* kb_base = KP + (size_t)(b * NMEM + l15) * DM + h * 256 + 8 * lq;
#pragma unroll
        for (int kb = 0; kb < 16; ++kb) { f32x4 acc = (f32x4){0.f, 0.f, 0.f, 0.f};
#pragma unroll
            for (int ks = 0; ks < 8; ++ks) { const bf16x8 Ka = *(const GAS bf16x8*)(kb_base + (size_t)(kb * 16) * DM + ks * 32); acc = __builtin_amdgcn_mfma_f32_16x16x32_bf16(Ka, Qb[ks], acc, 0, 0, 0); }
            ST[kb] = acc; }
        float mx = -3.0e38f;
#pragma unroll
        for (int kb = 0; kb < 16; ++kb) mx = fmaxf(mx, fmaxf(fmaxf(ST[kb].x, ST[kb].y), fmaxf(ST[kb].z, ST[kb].w)));
        mx = fmaxf(mx, __shfl_xor(mx, 16)); mx = fmaxf(mx, __shfl_xor(mx, 32));
        float sum = 0.f;
#pragma unroll
        for (int kb = 0; kb < 16; ++kb) { ST[kb].x = __expf(ST[kb].x - mx); ST[kb].y = __expf(ST[kb].y - mx); ST[kb].z = __expf(ST[kb].z - mx); ST[kb].w = __expf(ST[kb].w - mx); sum += (ST[kb].x + ST[kb].y) + (ST[kb].z + ST[kb].w); }
        sum += __shfl_xor(sum, 16); sum += __shfl_xor(sum, 32);
        const float inv = 1.0f / sum;
        bf16x8 Pb[8];
#pragma unroll
        for (int s = 0; s < 8; ++s) { v4u w; w.x = pk2(ST[2 * s].x, ST[2 * s].y); w.y = pk2(ST[2 * s].z, ST[2 * s].w); w.z = pk2(ST[2 * s + 1].x, ST[2 * s + 1].y); w.w = pk2(ST[2 * s + 1].z, ST[2 * s + 1].w); Pb[s] = __builtin_bit_cast(bf16x8, w); }
        const bf16* vt_base = VT + (size_t)(h * 256 + l15) * 2048 + b * NMEM + 4 * lq;
#pragma unroll 4
        for (int db = 0; db < 16; ++db) { f32x4 acc = (f32x4){0.f, 0.f, 0.f, 0.f};
#pragma unroll
            for (int s = 0; s < 8; ++s) { const bf16* vp = vt_base + (size_t)(db * 16) * 2048 + 32 * s; const v2u lo = *(const GAS v2u*)vp, hi = *(const GAS v2u*)(vp + 16);
                v4u w; w.x = lo.x; w.y = lo.y; w.z = hi.x; w.w = hi.y; acc = __builtin_amdgcn_mfma_f32_16x16x32_bf16(__builtin_bit_cast(bf16x8, w), Pb[s], acc, 0, 0, 0); }
            v2u w; w.x = pk2(acc.x * inv, acc.y * inv); w.y = pk2(acc.z * inv, acc.w * inv);
            *(GAS v2u*)(O + (size_t)(r0 + l15) * DM + h * 256 + db * 16 + 4 * lq) = w; }
    }
}
constexpr int ATP = 264;
static_assert(256 * ATP * 2 <= LDSCTL_OFF, "attention LDS");
__device__ __forceinline__ void attn_prompt2(const Frame& F, const bf16* Q, const bf16* KP, const bf16* VT, bf16* O) {
    LAS bf16* T = (LAS bf16*)F.lds;
    const int lane = F.lane, l15 = lane & 15, lq = lane >> 4, tid = F.tid;
    for (int ui = blockIdx.x; ui < BP * 4 * 8; ui += F.G) {
        const int qt = ui & 7, h = (ui >> 3) & 3, b = ui >> 5;
        const int r0 = b * LP + qt * 256 + F.wave * 32;
        __syncthreads();
        { const bf16* src = KP + (size_t)(b * NMEM) * DM + h * 256;
#pragma unroll 4
          for (int i = 0; i < 16; ++i) { const int item = tid + 512 * i, key = item >> 5, v = item & 31; *(LAS v4u*)(T + key * ATP + 8 * v) = *(const GAS v4u*)(src + (size_t)key * DM + 8 * v); } }
        __syncthreads();
        bf16x8 Pb[2][2][4]; float mxh[2][2], smh[2][2];
        {
            bf16x8 Qb[2][8];
#pragma unroll
            for (int qs = 0; qs < 2; ++qs)
#pragma unroll
                for (int ks = 0; ks < 8; ++ks) Qb[qs][ks] = *(const GAS bf16x8*)(Q + (size_t)(r0 + 16 * qs + l15) * DM + h * 256 + ks * 32 + 8 * lq);
#pragma unroll
            for (int hf = 0; hf < 2; ++hf) {
                f32x4 ST[2][8];
#pragma unroll
                for (int kb = 0; kb < 8; ++kb) { f32x4 a0 = (f32x4){0.f, 0.f, 0.f, 0.f}, a1 = (f32x4){0.f, 0.f, 0.f, 0.f};
#pragma unroll
                    for (int ks = 0; ks < 8; ++ks) { const bf16x8 Ka = *(const LAS bf16x8*)(T + ((hf * 8 + kb) * 16 + l15) * ATP + ks * 32 + 8 * lq); a0 = MFMA32(Ka, Qb[0][ks], a0); a1 = MFMA32(Ka, Qb[1][ks], a1); }
                    ST[0][kb] = a0; ST[1][kb] = a1; }
#pragma unroll
                for (int qs = 0; qs < 2; ++qs) {
                    float mx = -3.0e38f;
#pragma unroll
                    for (int kb = 0; kb < 8; ++kb) mx = fmaxf(mx, fmaxf(fmaxf(ST[qs][kb].x, ST[qs][kb].y), fmaxf(ST[qs][kb].z, ST[qs][kb].w)));
                    mx = fmaxf(mx, __shfl_xor(mx, 16)); mx = fmaxf(mx, __shfl_xor(mx, 32));
                    float sum = 0.f;
#pragma unroll
                    for (int kb = 0; kb < 8; ++kb) { f32x4 e; e.x = __expf(ST[qs][kb].x - mx); e.y = __expf(ST[qs][kb].y - mx); e.z = __expf(ST[qs][kb].z - mx); e.w = __expf(ST[qs][kb].w - mx); ST[qs][kb] = e; sum += (e.x + e.y) + (e.z + e.w); }
                    sum += __shfl_xor(sum, 16); sum += __shfl_xor(sum, 32);
                    mxh[hf][qs] = mx; smh[hf][qs] = sum;
#pragma unroll
                    for (int sI = 0; sI < 4; ++sI) { v4u w; w.x = pg8::cvt_pk_bf16(ST[qs][2 * sI].x, ST[qs][2 * sI].y); w.y = pg8::cvt_pk_bf16(ST[qs][2 * sI].z, ST[qs][2 * sI].w); w.z = pg8::cvt_pk_bf16(ST[qs][2 * sI + 1].x, ST[qs][2 * sI + 1].y); w.w = pg8::cvt_pk_bf16(ST[qs][2 * sI + 1].z, ST[qs][2 * sI + 1].w); Pb[hf][qs][sI] = __builtin_bit_cast(bf16x8, w); }
                }
            }
        }
        float c0[2], c1[2];
#pragma unroll
        for (int qs = 0; qs < 2; ++qs) { const float m = fmaxf(mxh[0][qs], mxh[1][qs]); const float e0 = __expf(mxh[0][qs] - m), e1 = __expf(mxh[1][qs] - m); const float inv = 1.0f / (e0 * smh[0][qs] + e1 * smh[1][qs]); c0[qs] = e0 * inv; c1[qs] = e1 * inv; }
        __syncthreads();
        { const bf16* src = VT + (size_t)(h * 256) * 2048 + b * NMEM;
#pragma unroll 4
          for (int i = 0; i < 16; ++i) { const int item = tid + 512 * i, d = item >> 5, v = item & 31; *(LAS v4u*)(T + d * ATP + 8 * v) = *(const GAS v4u*)(src + (size_t)d * 2048 + 8 * v); } }
        __syncthreads();
#pragma unroll 2
        for (int db = 0; db < 16; ++db) { f32x4 a00 = (f32x4){0.f, 0.f, 0.f, 0.f}, a01 = a00, a10 = a00, a11 = a00;
#pragma unroll
            for (int sI = 0; sI < 4; ++sI) {
                { const LAS bf16* vp = T + (db * 16 + l15) * ATP + 32 * sI + 4 * lq; const v2u lo = *(const LAS v2u*)vp, hi = *(const LAS v2u*)(vp + 16);
                  v4u w; w.x = lo.x; w.y = lo.y; w.z = hi.x; w.w = hi.y; const bf16x8 Va = __builtin_bit_cast(bf16x8, w); a00 = MFMA32(Va, Pb[0][0][sI], a00); a01 = MFMA32(Va, Pb[0][1][sI], a01); }
                { const LAS bf16* vp = T + (db * 16 + l15) * ATP + 128 + 32 * sI + 4 * lq; const v2u lo = *(const LAS v2u*)vp, hi = *(const LAS v2u*)(vp + 16);
                  v4u w; w.x = lo.x; w.y = lo.y; w.z = hi.x; w.w = hi.y; const bf16x8 Va = __builtin_bit_cast(bf16x8, w); a10 = MFMA32(Va, Pb[1][0][sI], a10); a11 = MFMA32(Va, Pb[1][1][sI], a11); } }
            const f32x4 o0 = a00 * c0[0] + a10 * c1[0], o1 = a01 * c0[1] + a11 * c1[1];
            v2u w0, w1; w0.x = pk2(o0.x, o0.y); w0.y = pk2(o0.z, o0.w); w1.x = pk2(o1.x, o1.y); w1.y = pk2(o1.z, o1.w);
            *(GAS v2u*)(O + (size_t)(r0 + l15) * DM + h * 256 + db * 16 + 4 * lq) = w0; *(GAS v2u*)(O + (size_t)(r0 + 16 + l15) * DM + h * 256 + db * 16 + 4 * lq) = w1; }
    }
    __syncthreads();
}
__device__ __forceinline__ void attn_sample(const Frame& F, const bf16* Q, const float* CK, const float* CV, bf16* O) {
    LAS float* redm = (LAS float*)F.lds;
    LAS float* reds = redm + 64;
    LAS float* Pl = reds + 64;
    LAS float* Ored = Pl + 8 * 256;
    const int lane = F.lane, l15 = lane & 15, lq = lane >> 4, wave = F.wave, tid = F.tid;
    for (int ui = blockIdx.x; ui < BS * 4; ui += F.G) {
        const int h = ui & 3, b = ui >> 2;
        bf16x8 Qb[8];
#pragma unroll
        for (int ks = 0; ks < 8; ++ks) { v4u w = (v4u){0u, 0u, 0u, 0u}; if (l15 < 8) w = *(const GAS v4u*)(Q + (size_t)(MP + b * LS + l15) * DM + h * 256 + ks * 32 + 8 * lq); Qb[ks] = __builtin_bit_cast(bf16x8, w); }
        f32x4 ST[2];
#pragma unroll
        for (int kb = 0; kb < 2; ++kb) { f32x4 acc = (f32x4){0.f, 0.f, 0.f, 0.f};
            const float* kp = CK + ((size_t)(b * NMEM + wave * 32 + kb * 16 + l15)) * DM + h * 256 + 8 * lq;
#pragma unroll
            for (int ks = 0; ks < 8; ++ks) { const f32x4 k0 = *(const GAS f32x4*)(kp + ks * 32), k1 = *(const GAS f32x4*)(kp + ks * 32 + 4);
                v4u w; w.x = pk2(k0.x, k0.y); w.y = pk2(k0.z, k0.w); w.z = pk2(k1.x, k1.y); w.w = pk2(k1.z, k1.w);
                acc = __builtin_amdgcn_mfma_f32_16x16x32_bf16(__builtin_bit_cast(bf16x8, w), Qb[ks], acc, 0, 0, 0); }
            ST[kb] = acc; }
        float mx = fmaxf(fmaxf(fmaxf(ST[0].x, ST[0].y), fmaxf(ST[0].z, ST[0].w)), fmaxf(fmaxf(ST[1].x, ST[1].y), fmaxf(ST[1].z, ST[1].w)));
        mx = fmaxf(mx, __shfl_xor(mx, 16)); mx = fmaxf(mx, __shfl_xor(mx, 32));
        if (lane < 8) redm[wave * 8 + lane] = mx;
        __syncthreads();
        float gm = -3.0e38f;
#pragma unroll
        for (int w = 0; w < 8; ++w) gm = fmaxf(gm, redm[w * 8 + (l15 & 7)]);
        float sum = 0.f;
#pragma unroll
        for (int kb = 0; kb < 2; ++kb) { ST[kb].x = __expf(ST[kb].x - gm); ST[kb].y = __expf(ST[kb].y - gm); ST[kb].z = __expf(ST[kb].z - gm); ST[kb].w = __expf(ST[kb].w - gm); sum += (ST[kb].x + ST[kb].y) + (ST[kb].z + ST[kb].w);
            if (l15 < 8) *(LAS f32x4*)(Pl + l15 * 256 + wave * 32 + kb * 16 + 4 * lq) = ST[kb]; }
        sum += __shfl_xor(sum, 16); sum += __shfl_xor(sum, 32);
        if (lane < 8) reds[wave * 8 + lane] = sum;
        __syncthreads();
        f32x4 o[8];
#pragma unroll
        for (int q = 0; q < 8; ++q) o[q] = (f32x4){0.f, 0.f, 0.f, 0.f};
        const float* vp = CV + ((size_t)(b * NMEM + wave * 32)) * DM + h * 256 + 4 * lane;
#pragma unroll 4
        for (int k = 0; k < 32; ++k) { const f32x4 v = *(const GAS f32x4*)(vp + (size_t)k * DM);
#pragma unroll
            for (int q = 0; q < 8; ++q) { const float pq = Pl[q * 256 + wave * 32 + k]; o[q] = o[q] + v * pq; } }
#pragma unroll
        for (int q = 0; q < 8; ++q) *(LAS f32x4*)(Ored + (wave * 8 + q) * 256 + 4 * lane) = o[q];
        __syncthreads();
        { const int q = tid >> 6, d4 = (tid & 63) * 4; float tot = 0.f;
#pragma unroll
          for (int w = 0; w < 8; ++w) tot += reds[w * 8 + q];
          f32x4 s = (f32x4){0.f, 0.f, 0.f, 0.f};
#pragma unroll
          for (int w = 0; w < 8; ++w) s = s + *(const LAS f32x4*)(Ored + (w * 8 + q) * 256 + d4);
          const float inv = 1.0f / tot; v2u w2; w2.x = pk2(s.x * inv, s.y * inv); w2.y = pk2(s.z * inv, s.w * inv);
          *(GAS v2u*)(O + (size_t)(MP + b * LS + q) * DM + h * 256 + d4) = w2; }
        __syncthreads();
    }
}

constexpr int REP_GEMM = 1, REP_SCAN = 1, REP_ATT = 1, REP_MISC = 1, REP_PRO = 1;
__device__ __forceinline__ int opq(int v) { asm volatile("" : "+s"(v)); return v; }
typedef const __attribute__((address_space(4))) Args* ArgsP;
__device__ __forceinline__ Frame make_frame(LAS unsigned char* lds) {
    Frame F; int t = threadIdx.x; asm volatile("" : "+v"(t));
    F.lds = lds; F.tid = t; F.lane = t & 63; F.wave = __builtin_amdgcn_readfirstlane(t >> 6);
    F.G = gridDim.x; { const int bx = blockIdx.x; F.vcu = (F.G % 8 == 0) ? (bx % 8) * (F.G / 8) + bx / 8 : bx; }
    F.gw = F.vcu * NWAVES + F.wave; F.NGW = F.G * NWAVES; F.gt = F.vcu * NTHR + F.tid; F.NGT = F.G * NTHR;
    return F;
}
#define PH_BEGIN ArgsP A_ = ap0; asm volatile("" : "+s"(A_)); const Frame F = make_frame(ldsp); unsigned char* const ws = A_->ws; float* const OUT = A_->out; (void)OUT; (void)ws

__global__ void __launch_bounds__(NTHR, 2) mega_fwd(Args args) {
    extern __shared__ __attribute__((aligned(16))) unsigned char lds[];
    LAS unsigned char* const ldsp = (LAS unsigned char*)lds;
    const ArgsP ap0 = (ArgsP)__builtin_amdgcn_kernarg_segment_ptr();
    XcdBarrier bar;
    { volatile LAS unsigned* MISC = (volatile LAS unsigned*)(ldsp + MISC_OFF);
      for (int u = threadIdx.x; u < (LDS_BYTES - LDSCTL_OFF) / 4; u += NTHR) ((LAS unsigned*)(ldsp + LDSCTL_OFF))[u] = 0u;
      __syncthreads();
      bar = xcd_barrier_post((unsigned*)(args.ws + WS_CTL) + 4096, MISC + 8); }
#define GRID_BAR() xcd_barrier(bar)

    for (int rep = 0, nrep_ = opq(REP_PRO); rep < nrep_; ++rep) { PH_BEGIN; p0_prologue(F, A_); }
    GRID_BAR();

    for (int rep = 0, nrep_ = opq(REP_GEMM); rep < nrep_; ++rep) { PH_BEGIN; pg8::Gemm g{(const bf16*)(ws + WS_MEMN), (const bf16*)(ws + WS_WMEM), BP * NMEM, 8192, DM, DM, -1}; pg8::StaticOrder S; S.init(g.M, g.N, F.G, (int)blockIdx.x);
      pg8::EpiMemKV E{OUT + O_MKP, OUT + O_MVP, (bf16*)(ws + WS_KP)};
      pg8::gemm_phase<pg8::EpiMemKV, pg8::StaticOrder>(F.lds, g, S, E); }
    for (int rep = 0, nrep_ = opq(REP_GEMM); rep < nrep_; ++rep) { PH_BEGIN; pg8::Gemm g{(const bf16*)(ws + WS_WMEM) + (size_t)4096 * DM, (const bf16*)(ws + WS_MEMN), 4096, BP * NMEM, DM, DM, -1}; pg8::StaticOrder S; S.init(g.M, g.N, F.G, (int)blockIdx.x);
      pg8::EpiBf16 E{(bf16*)(ws + WS_VT), BP * NMEM};
      pg8::gemm_phase<pg8::EpiBf16, pg8::StaticOrder>(F.lds, g, S, E); }

    for (int layer = 0; layer < DEPTH; ++layer) {
        const int kind = layer % 3, idx = layer / 3;
        for (int rep = 0, nrep_ = opq(REP_GEMM); rep < nrep_; ++rep) { PH_BEGIN;
          const bf16* win = kind == 0 ? (const bf16*)(ws + WS_RGWIN) + (size_t)idx * 4096 * DM : kind == 1 ? (const bf16*)(ws + WS_SSDWIN) : (const bf16*)(ws + WS_HGWIN);
          const int nin = kind == 0 ? 4096 : kind == 1 ? SSD_NPAD : 8192;
          pg8::Gemm g{(const bf16*)(ws + WS_XN), win, MT, nin, DM, DM, -1}; pg8::StaticOrder S; S.init(MT, nin, F.G, (int)blockIdx.x);
          pg8::EpiBf16 E{(bf16*)(ws + WS_P), nin};
          pg8::gemm_phase<pg8::EpiBf16, pg8::StaticOrder>(F.lds, g, S, E); }
        GRID_BAR();
        if (kind == 0) {
            for (int rep = 0, nrep_ = opq(REP_SCAN); rep < nrep_; ++rep) { PH_BEGIN;
              RgF rp{(const bf16*)(ws + WS_P), (const bf16*)(ws + WS_RGWAX) + (size_t)idx * 4096 * 256, A_->in[I_RG_CW] + (size_t)idx * 4 * BR, A_->in[I_RG_CB] + (size_t)idx * BR,
                     A_->in[I_RG_BA] + (size_t)idx * BR, A_->in[I_RG_BX] + (size_t)idx * BR, A_->in[I_RG_LAM] + (size_t)idx * BR,
                     A_->in[I_ST_RGC] + (size_t)idx * BS * 3 * BR, A_->in[I_ST_RGH] + (size_t)idx * BS * BR, (bf16*)(ws + WS_HGB),
                     OUT + O_RGCP + (size_t)idx * BP * 3 * BR, OUT + O_RGCS + (size_t)idx * BS * 3 * BR, OUT + O_RGHP + (size_t)idx * BP * BR, OUT + O_RGHS + (size_t)idx * BS * BR};
              rg_fused(F, rp, (gu32*)(ws + WS_CTL) + 8192 + 64 * (2 + idx) + 256 * rep); }
        } else if (kind == 1) {
            for (int rep = 0, nrep_ = opq(REP_MISC); rep < nrep_; ++rep) { PH_BEGIN;
              conv_phase<true>(F, (const bf16*)(ws + WS_P), SSD_NPAD, 2048, SSD_CONV, A_->in[I_ST_SC], A_->in[I_SSD_CW], A_->in[I_SSD_CB], (bf16*)(ws + WS_T1), OUT + O_SCP, OUT + O_SCS);
              ssd_dt_phase(F, (const bf16*)(ws + WS_P), A_->in[I_SSD_DTB], (float*)(ws + WS_DT)); }
            GRID_BAR();
            for (int rep = 0, nrep_ = opq(REP_SCAN); rep < nrep_; ++rep) { PH_BEGIN; ssd_prompt(F, (const bf16*)(ws + WS_T1), (const float*)(ws + WS_DT), A_->in[I_SSD_ALOG], (float*)(ws + WS_T2), (float*)(ws + WS_T3), OUT + O_SSP);
              ssd_scan(F, (const bf16*)(ws + WS_T1), (const float*)(ws + WS_DT), A_->in[I_SSD_ALOG], A_->in[I_ST_SS], (float*)(ws + WS_T2), OUT + O_SSS, (gu32*)(ws + WS_CTL) + 8192 + 64 * 1); }
            GRID_BAR();
            for (int rep = 0, nrep_ = opq(REP_MISC); rep < nrep_; ++rep) { PH_BEGIN; ssd_norm(F, (const float*)(ws + WS_T2), (const float*)(ws + WS_T3), (const bf16*)(ws + WS_T1), (const bf16*)(ws + WS_P), A_->in[I_SSD_D], (bf16*)(ws + WS_HGB)); }
        } else {
            for (int rep = 0, nrep_ = opq(REP_SCAN); rep < nrep_; ++rep) { PH_BEGIN; hgrn_prompt(F, (const bf16*)(ws + WS_P), (const float*)(ws + WS_LB) + (size_t)layer * BR, (float*)(ws + WS_T2), OUT + O_HSP);
              hgrn_scan(F, (const bf16*)(ws + WS_P), (const float*)(ws + WS_LB) + (size_t)layer * BR, A_->in[I_ST_HG], (float*)(ws + WS_T2), OUT + O_HSS, (gu32*)(ws + WS_CTL) + 8192 + 64 * 0); }
            GRID_BAR();
            for (int rep = 0, nrep_ = opq(REP_MISC); rep < nrep_; ++rep) { PH_BEGIN; hgrn_norm(F, (const float*)(ws + WS_T2), (const bf16*)(ws + WS_P), (bf16*)(ws + WS_HGB)); }
        }
        GRID_BAR();
        for (int rep = 0, nrep_ = opq(REP_GEMM); rep < nrep_; ++rep) { PH_BEGIN;
          const bf16* wout = kind == 0 ? (const bf16*)(ws + WS_RGWOUT) + (size_t)idx * DM * BR : kind == 1 ? (const bf16*)(ws + WS_SSDWOUT) : (const bf16*)(ws + WS_HGWOUT);
          pg8::Gemm g{(const bf16*)(ws + WS_HGB), wout, MT, DM, BR, BR, -1}; pg8::StaticOrder S; S.init(MT, DM, F.G, (int)blockIdx.x);
          pg8::EpiF32 E{(float*)(ws + WS_Y), DM};
          pg8::gemm_phase<pg8::EpiF32, pg8::StaticOrder>(F.lds, g, S, E); }
        GRID_BAR();
        { PH_BEGIN; thin_pass(F, (const float*)(ws + WS_Y), OUT, (bf16*)(ws + WS_XN), A_->in[I_NG] + (size_t)(layer * 4 + 1) * DM, true); }
        GRID_BAR();
        for (int rep = 0, nrep_ = opq(REP_GEMM); rep < nrep_; ++rep) { PH_BEGIN; pg8::Gemm g{(const bf16*)(ws + WS_XN), (const bf16*)(ws + WS_XWQ) + (size_t)layer * DM * DM, MT, DM, DM, DM, -1}; pg8::StaticOrder S; S.init(MT, DM, F.G, (int)blockIdx.x);
          pg8::EpiBf16 E{(bf16*)(ws + WS_Q), DM};
          pg8::gemm_phase<pg8::EpiBf16, pg8::StaticOrder>(F.lds, g, S, E); }
        GRID_BAR();
        for (int rep = 0, nrep_ = opq(REP_ATT); rep < nrep_; ++rep) { PH_BEGIN; attn_prompt2(F, (const bf16*)(ws + WS_Q), (const bf16*)(ws + WS_KP) + (size_t)layer * 2048 * DM, (const bf16*)(ws + WS_VT) + (size_t)layer * 1024 * 2048, (bf16*)(ws + WS_OA)); }
        for (int rep = 0, nrep_ = opq(REP_ATT); rep < nrep_; ++rep) { PH_BEGIN; attn_sample(F, (const bf16*)(ws + WS_Q), A_->in[I_CK] + (size_t)layer * BS * NMEM * DM, A_->in[I_CV] + (size_t)layer * BS * NMEM * DM, (bf16*)(ws + WS_OA)); }
        GRID_BAR();
        for (int rep = 0, nrep_ = opq(REP_GEMM); rep < nrep_; ++rep) { PH_BEGIN; pg8::Gemm g{(const bf16*)(ws + WS_OA), (const bf16*)(ws + WS_XWO) + (size_t)layer * DM * DM, MT, DM, DM, DM, -1}; pg8::StaticOrder S; S.init(MT, DM, F.G, (int)blockIdx.x);
          pg8::EpiF32 E{(float*)(ws + WS_Y), DM};
          pg8::gemm_phase<pg8::EpiF32, pg8::StaticOrder>(F.lds, g, S, E); }
        GRID_BAR();
        { PH_BEGIN; thin_pass(F, (const float*)(ws + WS_Y), OUT, (bf16*)(ws + WS_XN), A_->in[I_NG] + (size_t)(layer * 4 + 3) * DM, layer + 1 < DEPTH); }
        if (layer + 1 < DEPTH) GRID_BAR();
    }
}

extern "C" void kernel_launch(void* const* d_in, const int* in_sizes, int n_in, void* d_out, int out_size, void* d_ws, size_t ws_size, hipStream_t stream) {
    static int grid = 0;
    if (grid == 0) {
        if (n_in != N_IN || (size_t)out_size != O_END || ws_size < WS_END) { fprintf(stderr, "kernel_launch: unexpected sizes: n_in %d out %d ws %zu\n", n_in, out_size, ws_size); grid = -1; return; }
        int dev = 0, cus = 0, per_cu = 0;
        if (hipGetDevice(&dev) != hipSuccess || hipDeviceGetAttribute(&cus, hipDeviceAttributeMultiprocessorCount, dev) != hipSuccess) { grid = -1; return; }
        if (hipFuncSetAttribute((const void*)mega_fwd, hipFuncAttributeMaxDynamicSharedMemorySize, LDS_BYTES) != hipSuccess) { fprintf(stderr, "kernel_launch: hipFuncSetAttribute failed\n"); grid = -1; return; }
        if (hipOccupancyMaxActiveBlocksPerMultiprocessor(&per_cu, (const void*)mega_fwd, NTHR, LDS_BYTES) != hipSuccess || per_cu < 1) fprintf(stderr, "kernel_launch: occupancy query reports %d\n", per_cu);
        (void)hipGetLastError();
        grid = cus;
    }
    if (grid < 0) return;
    (void)hipMemsetAsync((char*)d_ws + WS_CTL, 0, CTL_ZERO_BYTES, stream);
    Args a{};
    for (int i = 0; i < N_IN; ++i) a.in[i] = (const float*)d_in[i];
    a.out = (float*)d_out; a.ws = (unsigned char*)d_ws;
    unsigned char* ws = (unsigned char*)d_ws;
    int nd = 0, items = 0;
    auto add = [&](const float* src, const float* gain, size_t dst_off, int K, int N, float scale) {
        WDesc& d = a.wd[nd++]; d.src = src; d.gain = gain; d.dst = (bf16*)(ws + dst_off); d.K = K; d.N = N; d.scale = scale; d.item0 = items; items += (K / 64) * (N / 32); };
    const float* NG = a.in[I_NG];
    for (int l = 0; l < DEPTH; ++l) {
        add(a.in[I_XWK] + (size_t)l * DM * DM, a.in[I_MNG] + (size_t)l * DM, WS_WMEM + ((size_t)l * 1024) * DM * 2, DM, DM, 1.f);
        add(a.in[I_XWV] + (size_t)l * DM * DM, a.in[I_MNG] + (size_t)l * DM, WS_WMEM + ((size_t)4096 + (size_t)l * 1024) * DM * 2, DM, DM, 1.f);
    }
    for (int i = 0; i < 2; ++i) {
        const int layer = 3 * i;
        add(a.in[I_RG_WIN] + (size_t)i * DM * 4096, NG + (size_t)(layer * 4 + 0) * DM, WS_RGWIN + (size_t)i * 4096 * DM * 2, DM, 4096, 1.f);
        for (int j = 0; j < 8; ++j) {
            add(a.in[I_RG_WA] + ((size_t)i * 8 + j) * 256 * 256, nullptr, WS_RGWAX + ((size_t)i * 4096 + (size_t)j * 512) * 256 * 2, 256, 256, 1.f);
            add(a.in[I_RG_WX] + ((size_t)i * 8 + j) * 256 * 256, nullptr, WS_RGWAX + ((size_t)i * 4096 + (size_t)j * 512 + 256) * 256 * 2, 256, 256, 1.f);
        }
        add(a.in[I_RG_WOUT] + (size_t)i * BR * DM, nullptr, WS_RGWOUT + (size_t)i * DM * BR * 2, BR, DM, 1.f);
    }
    add(a.in[I_SSD_WIN], NG + (size_t)(1 * 4 + 0) * DM, WS_SSDWIN, DM, SSD_NIN, 1.f);
    add(a.in[I_SSD_WOUT], a.in[I_SSD_NG], WS_SSDWOUT, BR, DM, 1.f);
    add(a.in[I_HG_WIN], NG + (size_t)(2 * 4 + 0) * DM, WS_HGWIN, DM, 8192, 1.f);
    add(a.in[I_HG_WOUT], a.in[I_HG_NG], WS_HGWOUT, BR, DM, 1.f);
    for (int l = 0; l < DEPTH; ++l) {
        add(a.in[I_XWQ] + (size_t)l * DM * DM, NG + (size_t)(l * 4 + 2) * DM, WS_XWQ + (size_t)l * DM * DM * 2, DM, DM, 0.0625f);
        add(a.in[I_XWO] + (size_t)l * DM * DM, nullptr, WS_XWO + (size_t)l * DM * DM * 2, DM, DM, 1.f);
    }
    if (nd != NWD) { fprintf(stderr, "kernel_launch: descriptor count %d != %d\n", nd, NWD); return; }
    a.nitems = items; a.pad = 0;
    hipLaunchKernelGGL(mega_fwd, dim3(grid), dim3(NTHR), LDS_BYTES, stream, a);
    const hipError_t le = hipPeekAtLastError();
    if (le != hipSuccess) fprintf(stderr, "kernel_launch: launch failed: %s\n", hipGetErrorName(le));
}
```
